# Optimizing an MI355X kernel written in HIP

```python
import math
import jax, jax.numpy as jnp
from jax import lax
import numpy as np

D_MODEL = 1024
BATCH = 8
SEQ = 4096
DEPTH = 4
DEC_BATCH = 8
DEC_SEQ = 16
PAST_LEN = 1024

CHUNK = 64
N_META = 16
QBLOCK = 128
EPS = 1e-6
H_A = 8
HD_A = 64
DA = H_A * 2 * HD_A
H_B = 8
Q_LORA = 768
KV_LORA = 256
NOPE_B = 64
ROPE_B = 32
V_B = 64
ROPE_THETA = 10000.0
NUM_BUCKETS = 32
MAX_DISTANCE = 128
D_FF = 2816
CONV_W = 3
IN_SPLITS = (DA, 2 * DA, 3 * DA, 3 * DA + Q_LORA, 3 * DA + Q_LORA + KV_LORA + ROPE_B,
             3 * DA + Q_LORA + KV_LORA + ROPE_B + D_MODEL)
N_IN = 3 * DA + Q_LORA + KV_LORA + ROPE_B + 2 * D_MODEL

kernel_name = "hybrid_diffattn_mla_convffn_stream_step"


def rms_norm(x, g):
    xf = x.astype(jnp.float32)
    y = xf * lax.rsqrt(jnp.mean(xf * xf, axis=-1, keepdims=True) + EPS)
    return (y * g.astype(jnp.float32)).astype(x.dtype)


def t5_bucket(rel):
    half = NUM_BUCKETS // 2
    max_exact = half // 2
    n = jnp.abs(rel)
    nf = jnp.maximum(n, 1).astype(jnp.float32)
    large = max_exact + (jnp.log(nf / max_exact) / math.log(MAX_DISTANCE / max_exact)
                         * (half - max_exact)).astype(jnp.int32)
    large = jnp.minimum(large, half - 1)
    return jnp.where(rel > 0, half, 0) + jnp.where(n < max_exact, n, large)


def rope(x, pos):
    half = ROPE_B // 2
    inv = ROPE_THETA ** (-jnp.arange(half, dtype=jnp.float32) / half)
    ang = pos.astype(jnp.float32)[:, None] * inv[None, :]
    shape = (1, pos.shape[0]) + (1,) * (x.ndim - 3) + (half,)
    c = jnp.cos(ang).reshape(shape)
    s = jnp.sin(ang).reshape(shape)
    xf = x.astype(jnp.float32)
    x1, x2 = xf[..., :half], xf[..., half:]
    return jnp.concatenate([x1 * c - x2 * s, x1 * s + x2 * c], axis=-1).astype(x.dtype)


def bcast(a, n):
    return jnp.broadcast_to(a, (n,) + a.shape[1:])


def over_query_blocks(fn, q_arrays, q_pos):
    lq = q_pos.shape[0]
    blk = min(QBLOCK, lq)
    nb = -(-lq // blk)
    pad = nb * blk - lq

    def split(a):
        a = jnp.pad(a, [(0, 0), (0, pad)] + [(0, 0)] * (a.ndim - 2))
        return jnp.moveaxis(a.reshape((a.shape[0], nb, blk) + a.shape[2:]), 1, 0)

    qs = tuple(split(a) for a in q_arrays)
    ps = jnp.pad(q_pos, (0, pad), mode="edge").reshape(nb, blk)
    out = lax.map(lambda args: fn(args[0], args[1]), (qs, ps))
    out = jnp.moveaxis(out, 0, 1)
    out = out.reshape((out.shape[0], nb * blk) + out.shape[3:])
    return out[:, :lq]


def diff_attention(q, k, v, q_pos, k_pos, lam, bias_table):
    scale = HD_A ** -0.5
    k_chunk = k_pos // CHUNK

    def block(qs, pos):
        (qb,) = qs
        s = jnp.einsum("bqhmd,bkhmd->bhmqk", qb, k).astype(jnp.float32) * scale
        bias = jnp.transpose(bias_table[t5_bucket(k_pos[None, :] - pos[:, None])], (2, 0, 1))
        s = s + bias.astype(jnp.float32)[None, :, None]
        mask = k_chunk[None, :] <= (pos // CHUNK)[:, None]
        p = jax.nn.softmax(jnp.where(mask, s, -jnp.inf), axis=-1)
        pd = p[:, :, 0] - lam * p[:, :, 1]
        return jnp.einsum("bhqk,bkhe->bqhe", pd, v).astype(v.dtype)

    return over_query_blocks(block, (q,), q_pos)


def mla_attention(q_nope, q_pe, k_nope, k_pe, v, q_pos, k_pos):
    scale = (NOPE_B + ROPE_B) ** -0.5
    k_chunk = k_pos // CHUNK

    def block(qs, pos):
        qn, qp = qs
        s = (jnp.einsum("bqhn,bkhn->bhqk", qn, k_nope)
             + jnp.einsum("bqhe,bke->bhqk", qp, k_pe)).astype(jnp.float32) * scale
        mask = k_chunk[None, :] <= (pos // CHUNK)[:, None]
        p = jax.nn.softmax(jnp.where(mask, s, -jnp.inf), axis=-1)
        return jnp.einsum("bhqk,bkhe->bqhe", p, v).astype(v.dtype)

    return over_query_blocks(block, (q_nope, q_pe), q_pos)


def trunk_layer(h, past_ak, past_av, past_ckv, past_kr, conv_buf, q_pos, k_pos, lam_init, bias_table, lw):
    (norm_mix_g, w_in, a_lambda, a_subln_g, b_q_norm_g, w_b_uq, b_kv_norm_g, w_b_ukv,
     w_a_br, w_b_br, w_out, norm_ffn_g, w_up, conv_w, conv_b, w_down) = lw
    b, L, _ = h.shape
    hn = rms_norm(h, norm_mix_g)
    z = jnp.einsum("bld,dn->bln", hn, w_in)
    qa, ka, va, cq, dkv, ga, gb = jnp.split(z, IN_SPLITS, axis=-1)

    qa = qa.reshape(b, L, H_A, 2, HD_A)
    ka = ka.reshape(b, L, H_A, 2 * HD_A)
    va = va.reshape(b, L, H_A, 2 * HD_A)
    k_all = jnp.concatenate([past_ak, ka], axis=1).reshape(b, -1, H_A, 2, HD_A)
    v_all = jnp.concatenate([past_av, va], axis=1)
    al = a_lambda.astype(jnp.float32)
    lam = jnp.exp(jnp.sum(al[0] * al[1])) - jnp.exp(jnp.sum(al[2] * al[3])) + lam_init
    oa = diff_attention(qa, k_all, v_all, q_pos, k_pos, lam, bias_table)
    oa = rms_norm(oa, a_subln_g) * (1.0 - lam_init)
    oa = jnp.einsum("blc,cd->bld", oa.reshape(b, L, DA), w_a_br)

    cq = rms_norm(cq, b_q_norm_g)
    qb = jnp.einsum("blr,rhe->blhe", cq, w_b_uq)
    q_nope = qb[..., :NOPE_B]
    q_pe = rope(qb[..., NOPE_B:], q_pos)
    ckv = rms_norm(dkv[..., :KV_LORA], b_kv_norm_g)
    kr = rope(dkv[..., KV_LORA:], q_pos)
    ckv_all = jnp.concatenate([past_ckv, ckv], axis=1)
    kr_all = jnp.concatenate([past_kr, kr], axis=1)
    kv_up = jnp.einsum("bkr,rhe->bkhe", ckv_all, w_b_ukv)
    ob = mla_attention(q_nope, q_pe, kv_up[..., :NOPE_B], kr_all, kv_up[..., NOPE_B:], q_pos, k_pos)
    ob = jnp.einsum("blc,cd->bld", ob.reshape(b, L, H_B * V_B), w_b_br)

    m = jax.nn.sigmoid(ga) * oa + jax.nn.sigmoid(gb) * ob
    h = h + jnp.einsum("bld,de->ble", m, w_out)

    hn2 = rms_norm(h, norm_ffn_g)
    u = jnp.einsum("bld,df->blf", hn2, w_up)
    ext = jnp.concatenate([conv_buf.astype(u.dtype), u], axis=1)
    c = conv_b + sum(conv_w[j] * ext[:, j:j + L] for j in range(CONV_W))
    a_up, g_up = jnp.split(c, 2, axis=-1)
    h = h + jnp.einsum("blf,fd->bld", jax.nn.silu(g_up) * a_up, w_down)
    return h, (ka, va, ckv, kr, ext[:, -(CONV_W - 1):])


def setup_inputs(seed: int = 0) -> dict:
    key = jax.random.key(seed)
    ks = jax.random.split(key, 28)
    f32 = jnp.float32

    def nrm(k, shape, scale=1.0):
        return jax.random.normal(k, shape, f32) * scale

    def gain(k, shape):
        return 1.0 + 0.05 * jax.random.normal(k, shape, f32)

    return {
        "x_prompt": nrm(ks[0], (BATCH, SEQ, D_MODEL)),
        "x_sample": nrm(ks[1], (DEC_BATCH, DEC_SEQ, D_MODEL)),
        "cache_a_k": nrm(ks[2], (DEPTH, DEC_BATCH, PAST_LEN, H_A, 2 * HD_A)),
        "cache_a_v": nrm(ks[3], (DEPTH, DEC_BATCH, PAST_LEN, H_A, 2 * HD_A)),
        "cache_b_ckv": nrm(ks[4], (DEPTH, DEC_BATCH, PAST_LEN, KV_LORA)),
        "cache_b_krope": nrm(ks[5], (DEPTH, DEC_BATCH, PAST_LEN, ROPE_B)),
        "state_ffn_conv": nrm(ks[6], (DEPTH, DEC_BATCH, CONV_W - 1, 2 * D_FF)),
        "meta_tokens": nrm(ks[7], (N_META, D_MODEL)),
        "rel_bias_table": nrm(ks[8], (NUM_BUCKETS, H_A), 0.5),
        "norm_mix_g": gain(ks[9], (DEPTH, D_MODEL)),
        "w_in": nrm(ks[10], (DEPTH, D_MODEL, N_IN), D_MODEL ** -0.5),
        "a_lambda": nrm(ks[11], (DEPTH, 4, HD_A), 0.1),
        "a_subln_g": gain(ks[12], (DEPTH, 2 * HD_A)),
        "b_q_norm_g": gain(ks[13], (DEPTH, Q_LORA)),
        "w_b_uq": nrm(ks[14], (DEPTH, Q_LORA, H_B, NOPE_B + ROPE_B), Q_LORA ** -0.5),
        "b_kv_norm_g": gain(ks[15], (DEPTH, KV_LORA)),
        "w_b_ukv": nrm(ks[16], (DEPTH, KV_LORA, H_B, NOPE_B + V_B), KV_LORA ** -0.5),
        "w_a_br": nrm(ks[17], (DEPTH, DA, D_MODEL), DA ** -0.5),
        "w_b_br": nrm(ks[18], (DEPTH, H_B * V_B, D_MODEL), (H_B * V_B) ** -0.5),
        "w_out": nrm(ks[19], (DEPTH, D_MODEL, D_MODEL), D_MODEL ** -0.5),
        "norm_ffn_g": gain(ks[20], (DEPTH, D_MODEL)),
        "w_up": nrm(ks[21], (DEPTH, D_MODEL, 2 * D_FF), D_MODEL ** -0.5),
        "conv_w": nrm(ks[22], (DEPTH, CONV_W, 2 * D_FF), CONV_W ** -0.5),
        "conv_b": nrm(ks[23], (DEPTH, 2 * D_FF), 0.02),
        "w_down": nrm(ks[24], (DEPTH, D_FF, D_MODEL), D_FF ** -0.5),
        "final_norm_g": gain(ks[25], (D_MODEL,)),
    }


def reference(x_prompt, x_sample, cache_a_k, cache_a_v, cache_b_ckv, cache_b_krope, state_ffn_conv,
              meta_tokens, rel_bias_table, norm_mix_g, w_in, a_lambda, a_subln_g, b_q_norm_g, w_b_uq,
              b_kv_norm_g, w_b_ukv, w_a_br, w_b_br, w_out, norm_ffn_g, w_up, conv_w, conv_b, w_down,
              final_norm_g):
    bp, seq = x_prompt.shape[0], x_prompt.shape[1]
    bs, dec = x_sample.shape[0], x_sample.shape[1]
    past_len = cache_a_k.shape[2]
    dt = x_prompt.dtype
    meta_pos = jnp.arange(-N_META, 0, dtype=jnp.int32)
    prompt_pos = jnp.arange(seq, dtype=jnp.int32)
    sample_pos = jnp.arange(past_len, past_len + dec, dtype=jnp.int32)
    kpos_prompt = jnp.concatenate([meta_pos, prompt_pos])
    kpos_sample = jnp.concatenate([meta_pos, jnp.arange(past_len, dtype=jnp.int32), sample_pos])

    h_meta = meta_tokens[None].astype(dt)
    h_p = x_prompt
    h_s = x_sample
    ak_p, ak_s, av_p, av_s, ck_p, ck_s, kr_p, kr_s, cv_p, cv_s = ([] for _ in range(10))
    for l in range(DEPTH):
        lam_init = 0.8 - 0.6 * math.exp(-0.3 * l)
        lw = (norm_mix_g[l], w_in[l], a_lambda[l], a_subln_g[l], b_q_norm_g[l], w_b_uq[l], b_kv_norm_g[l],
              w_b_ukv[l], w_a_br[l], w_b_br[l], w_out[l], norm_ffn_g[l], w_up[l], conv_w[l], conv_b[l],
              w_down[l])
        h_meta, (mk, mv, mc, mr, mbuf) = trunk_layer(
            h_meta,
            jnp.zeros((1, 0, H_A, 2 * HD_A), dt), jnp.zeros((1, 0, H_A, 2 * HD_A), dt),
            jnp.zeros((1, 0, KV_LORA), dt), jnp.zeros((1, 0, ROPE_B), dt),
            jnp.zeros((1, CONV_W - 1, 2 * D_FF), dt),
            meta_pos, meta_pos, lam_init, rel_bias_table, lw)
        h_p, (pk, pv, pc, pr, pbuf) = trunk_layer(
            h_p, bcast(mk, bp), bcast(mv, bp), bcast(mc, bp), bcast(mr, bp), bcast(mbuf, bp),
            prompt_pos, kpos_prompt, lam_init, rel_bias_table, lw)
        h_s, (sk, sv, sc, sr, sbuf) = trunk_layer(
            h_s,
            jnp.concatenate([bcast(mk, bs), cache_a_k[l]], axis=1),
            jnp.concatenate([bcast(mv, bs), cache_a_v[l]], axis=1),
            jnp.concatenate([bcast(mc, bs), cache_b_ckv[l]], axis=1),
            jnp.concatenate([bcast(mr, bs), cache_b_krope[l]], axis=1),
            state_ffn_conv[l],
            sample_pos, kpos_sample, lam_init, rel_bias_table, lw)
        ak_p.append(jnp.concatenate([bcast(mk, bp), pk], axis=1))
        av_p.append(jnp.concatenate([bcast(mv, bp), pv], axis=1))
        ck_p.append(jnp.concatenate([bcast(mc, bp), pc], axis=1))
        kr_p.append(jnp.concatenate([bcast(mr, bp), pr], axis=1))
        cv_p.append(pbuf)
        ak_s.append(sk)
        av_s.append(sv)
        ck_s.append(sc)
        kr_s.append(sr)
        cv_s.append(sbuf)

    y_prompt = rms_norm(h_p, final_norm_g)
    y_sample = rms_norm(h_s, final_norm_g)
    return (y_prompt, y_sample,
            jnp.stack(ak_p), jnp.stack(ak_s), jnp.stack(av_p), jnp.stack(av_s),
            jnp.stack(ck_p), jnp.stack(ck_s), jnp.stack(kr_p), jnp.stack(kr_s),
            jnp.stack(cv_p), jnp.stack(cv_s))
```

```cpp
#include <hip/hip_runtime.h>
#include <hip/hip_cooperative_groups.h>
#include <cstdio>
#include <cstdint>
namespace cg = cooperative_groups;
namespace pg8 {
#define PG8_LAS __attribute__((address_space(3)))
typedef unsigned short bf16_t;
typedef short bf16x8 __attribute__((ext_vector_type(8)));
typedef float f32x4 __attribute__((ext_vector_type(4)));
typedef unsigned u32x4 __attribute__((ext_vector_type(4)));
constexpr int BM = 256, BK = 64, HALF = 128, HTB = HALF * BK * 2  , STAGE_BYTES = 8 * HTB, NXCD = 8, WGM = 8;

__host__ __device__ __forceinline__ int lds_byte(int r, int c) { const int st = (r >> 4) * 2 + (c >> 5), rr = r & 15, cc = c & 31, ob = rr * 64 + cc * 2; return st * 1024 + (ob ^ (((ob >> 9) & 1) << 5)); }
__host__ __device__ __forceinline__ void stage_rc(int b, int& R, int& C) { const int st = b / 1024, sb = b % 1024, swz = sb ^ (((sb >> 9) & 1) << 5); R = (st >> 1) * 16 + swz / 64; C = (st & 1) * 32 + (swz % 64) / 2; }
__host__ __device__ __forceinline__ int perm32(int rho) { const int n = rho >> 4, i = rho & 15; return 8 * (i >> 2) + 4 * n + (i & 3); }

struct Unit { int pm, pn, k0, nt; };
struct Gemm { const bf16_t* A; const bf16_t* Bt; int M, N, K; };

struct StaticOrder {
    int nM, nN, nwg, G, c, ntf, tail_pm, nsplit, ksub;
    __host__ __device__ void init(int M, int N, int G_, int c_, int K_ = 0, int tail_pm_ = -1, int nsplit_ = 0) { nM = M / BM; nN = N / BM; nwg = nM * nN; G = G_; c = c_; ntf = K_ / BK; tail_pm = tail_pm_; nsplit = nsplit_; ksub = nsplit_ ? K_ / nsplit_ : 0; }
    __host__ __device__ bool next(int i, Unit& u) const {
        const long L = (long)i * G + c;
        if (L >= nwg) { const int idx = (int)(L - nwg); if (idx >= nN * nsplit) return false;
            u.pm = tail_pm; u.pn = idx % nN; u.k0 = (idx / nN) * ksub; u.nt = ksub / BK; return true; }
        int wgid = (int)L; { const int q = nwg / NXCD, r = nwg % NXCD, xcd = wgid % NXCD, off = wgid / NXCD; wgid = (xcd < r ? xcd * (q + 1) : r * (q + 1) + (xcd - r) * q) + off; }
        const int nig = WGM * nN, gid = wgid / nig, fm = gid * WGM, gsz = (nM - fm) < WGM ? (nM - fm) : WGM;
        u.pm = fm + ((wgid % nig) % gsz); u.pn = (wgid % nig) / gsz; u.k0 = 0; u.nt = ntf; return true;
    }
    __device__ __forceinline__ void a_ready(const Unit&) const {}
    __device__ __forceinline__ void done(const Unit&) const {}
};

__device__ __forceinline__ unsigned cvt_pk_bf16(float lo, float hi) { unsigned r; asm volatile("v_cvt_pk_bf16_f32 %0, %1, %2" : "=v"(r) : "v"(lo), "v"(hi)); return r; }
typedef float f32x2 __attribute__((ext_vector_type(2)));
template <class Epi, class Sched, bool ALIGN_EPI = false, bool SP2 = false>
__device__ __forceinline__ void gemm_phase(PG8_LAS unsigned char* lds, const Gemm g, const Sched& S, const Epi& E) {
    int tid_ = threadIdx.x; asm volatile("" : "+v"(tid_));
    const int tid = tid_, wid = __builtin_amdgcn_readfirstlane(tid >> 6), lane = tid & 63, wr = wid >> 2, wc = wid & 3, fr = lane & 15, fq = lane >> 4;
    const int K = g.K;
    unsigned voffA[2], voffB[2];
#pragma unroll
    for (int i = 0; i < 2; ++i) { int R, C; stage_rc(tid * 16 + i * 8192, R, C); const int Rb = Epi::PERM ? ((R & ~31) + perm32(R & 31)) : R;
        voffA[i] = (unsigned)(R * K + C) * 2u; voffB[i] = (unsigned)(Rb * K + C) * 2u; }
    const size_t kstep = (size_t)(BK * 2);
    const size_t hstep = (size_t)HALF * K * 2;
    const size_t tstep = 2 * hstep;
    const unsigned ldsw = (unsigned)wid * 1024u;
    const int aoff = lds_byte(wr * 64 + fr, fq * 8), boff = lds_byte(wc * 32 + fr, fq * 8);
#define PG8_SA(b, h) (((b) * 2 + (h)) * HTB)
#define PG8_SB(b, h) ((4 + (b) * 2 + (h)) * HTB)
#define PG8_STAGE(bufoff, gbase, voff) do { _Pragma("unroll") for (int _i = 0; _i < 2; ++_i) \
        __builtin_amdgcn_global_load_lds((const unsigned*)((const char*)(gbase) + (voff)[_i]), (PG8_LAS unsigned*)(lds + (bufoff) + ldsw + _i * 8192), 16, 0, 0); } while (0)
#define PG8_LDA(dst, b, h) do { _Pragma("unroll") for (int m = 0; m < 4; ++m) _Pragma("unroll") for (int k = 0; k < 2; ++k) dst[m][k] = *(const PG8_LAS bf16x8*)(lds + PG8_SA(b, h) + aoff + m * 2048 + k * 1024); } while (0)
#define PG8_LDB(dst, b, h) do { _Pragma("unroll") for (int n = 0; n < 2; ++n) _Pragma("unroll") for (int k = 0; k < 2; ++k) dst[n][k] = *(const PG8_LAS bf16x8*)(lds + PG8_SB(b, h) + boff + n * 2048 + k * 1024); } while (0)
#define PG8_MMA(ai, bj, At, Bt) do { __builtin_amdgcn_s_setprio(1); _Pragma("unroll") for (int m = 0; m < 4; ++m) _Pragma("unroll") for (int n = 0; n < 2; ++n) _Pragma("unroll") for (int k = 0; k < 2; ++k) \
        acc[ai][bj][m][n] = __builtin_amdgcn_mfma_f32_16x16x32_bf16(Bt[n][k], At[m][k], acc[ai][bj][m][n], 0, 0, 0); __builtin_amdgcn_s_setprio(0); } while (0)
#define PG8_WAIT_V(n) asm volatile("s_waitcnt vmcnt(" #n ")" ::: "memory")
#define PG8_WAIT_L(n) asm volatile("s_waitcnt lgkmcnt(" #n ")" ::: "memory")
#define PG8_BAR __builtin_amdgcn_s_barrier()
#define PG8_SCHED __builtin_amdgcn_sched_barrier(0)
    Unit cur, nxt; int ui = 0;
    if (!S.next(0, cur)) return;
    f32x4 acc[2][2][4][2];
#pragma unroll
    for (int a = 0; a < 2; ++a)
#pragma unroll
        for (int b = 0; b < 2; ++b)
#pragma unroll
            for (int m = 0; m < 4; ++m)
#pragma unroll
                for (int n = 0; n < 2; ++n) acc[a][b][m][n] = (f32x4){0.f, 0.f, 0.f, 0.f};
    bf16x8 At[4][2], B0[2][2], B1[2][2];
    const char* cA = (const char*)g.A + (size_t)cur.pm * tstep + (size_t)cur.k0 * 2; const char* cB = (const char*)g.Bt + (size_t)cur.pn * tstep + (size_t)cur.k0 * 2;
    S.a_ready(cur);
    if constexpr (SP2) {
        PG8_STAGE(PG8_SB(0, 0), cB, voffB); PG8_STAGE(PG8_SB(0, 1), cB + hstep, voffB); PG8_STAGE(PG8_SA(0, 0), cA, voffA); PG8_STAGE(PG8_SA(0, 1), cA + hstep, voffA);
        if (wr == 1) PG8_BAR;
        PG8_WAIT_V(2); PG8_BAR;
        PG8_STAGE(PG8_SB(1, 0), cB + kstep, voffB); PG8_STAGE(PG8_SA(1, 0), cA + kstep, voffA); PG8_STAGE(PG8_SB(1, 1), cB + hstep + kstep, voffB);
        PG8_WAIT_V(6); PG8_BAR;
    } else {
        PG8_STAGE(PG8_SB(0, 0), cB, voffB); PG8_STAGE(PG8_SA(0, 0), cA, voffA); PG8_STAGE(PG8_SB(0, 1), cB + hstep, voffB); PG8_STAGE(PG8_SA(0, 1), cA + hstep, voffA);
        if (wr == 1) PG8_BAR;
        PG8_WAIT_V(4); PG8_BAR;
        PG8_STAGE(PG8_SB(1, 0), cB + kstep, voffB); PG8_STAGE(PG8_SA(1, 0), cA + kstep, voffA); PG8_STAGE(PG8_SB(1, 1), cB + hstep + kstep, voffB);
        PG8_WAIT_V(6); PG8_BAR;
    }
    for (;;) {
        const bool has_next = S.next(ui + 1, nxt);
        const char* nA = has_next ? (const char*)g.A + (size_t)nxt.pm * tstep + (size_t)nxt.k0 * 2 : cA; const char* nB = has_next ? (const char*)g.Bt + (size_t)nxt.pn * tstep + (size_t)nxt.k0 * 2 : cB;
        const int ntc = cur.nt;
        for (int t = 0; t < ntc; t += 2) {
            const bool last = (t == ntc - 2);
            const char* a1 = cA + (size_t)(t + 1) * kstep;
            const char* a2 = last ? nA : cA + (size_t)(t + 2) * kstep; const char* b2 = last ? nB : cB + (size_t)(t + 2) * kstep;
            const char* a3 = a2 + kstep; const char* b3 = b2 + kstep;
            if (last && has_next) S.a_ready(nxt);
            if constexpr (SP2) {
            PG8_LDB(B0, 0, 0); PG8_LDB(B1, 0, 1); PG8_SCHED; PG8_LDA(At, 0, 0); PG8_STAGE(PG8_SA(1, 1), a1 + hstep, voffA);
            PG8_WAIT_V(8); PG8_WAIT_L(0); PG8_BAR; PG8_MMA(0, 0, At, B0); PG8_MMA(0, 1, At, B1); PG8_BAR; PG8_SCHED;
            PG8_LDA(At, 0, 1); PG8_STAGE(PG8_SB(0, 0), b2, voffB); PG8_STAGE(PG8_SB(0, 1), b2 + hstep, voffB); PG8_STAGE(PG8_SA(0, 0), a2, voffA);
            PG8_WAIT_V(8); PG8_WAIT_L(0); PG8_BAR; PG8_MMA(1, 0, At, B0); PG8_MMA(1, 1, At, B1); PG8_BAR; PG8_SCHED;
            PG8_LDB(B0, 1, 0); PG8_LDB(B1, 1, 1); PG8_SCHED; PG8_LDA(At, 1, 0); PG8_STAGE(PG8_SA(0, 1), a2 + hstep, voffA);
            PG8_WAIT_V(8); PG8_WAIT_L(0); PG8_BAR; PG8_MMA(0, 0, At, B0); PG8_MMA(0, 1, At, B1); PG8_BAR; PG8_SCHED;
            PG8_LDA(At, 1, 1); PG8_STAGE(PG8_SB(1, 0), b3, voffB); PG8_STAGE(PG8_SB(1, 1), b3 + hstep, voffB); PG8_STAGE(PG8_SA(1, 0), a3, voffA);
            PG8_WAIT_V(8); PG8_WAIT_L(0); PG8_BAR; PG8_MMA(1, 0, At, B0); PG8_MMA(1, 1, At, B1); PG8_BAR; PG8_SCHED;
            } else {
            PG8_LDB(B0, 0, 0); PG8_SCHED; PG8_LDA(At, 0, 0); PG8_STAGE(PG8_SA(1, 1), a1 + hstep, voffA);
            PG8_WAIT_L(8); PG8_BAR; PG8_WAIT_L(0); PG8_MMA(0, 0, At, B0); PG8_BAR; PG8_SCHED;
            PG8_LDB(B1, 0, 1); PG8_STAGE(PG8_SB(0, 0), b2, voffB);
            PG8_BAR; PG8_WAIT_L(0); PG8_MMA(0, 1, At, B1); PG8_BAR;
            PG8_LDA(At, 0, 1); PG8_STAGE(PG8_SA(0, 0), a2, voffA);
            PG8_BAR; PG8_WAIT_L(0); PG8_MMA(1, 0, At, B0); PG8_BAR; PG8_SCHED;
            PG8_STAGE(PG8_SB(0, 1), b2 + hstep, voffB);
            PG8_WAIT_V(6); PG8_BAR; PG8_MMA(1, 1, At, B1); PG8_BAR;
            PG8_LDB(B0, 1, 0); PG8_SCHED; PG8_LDA(At, 1, 0); PG8_STAGE(PG8_SA(0, 1), a2 + hstep, voffA);
            PG8_WAIT_L(8); PG8_BAR; PG8_WAIT_L(0); PG8_MMA(0, 0, At, B0); PG8_BAR; PG8_SCHED;
            PG8_LDB(B1, 1, 1); PG8_STAGE(PG8_SB(1, 0), b3, voffB);
            PG8_BAR; PG8_WAIT_L(0); PG8_MMA(0, 1, At, B1); PG8_BAR;
            PG8_LDA(At, 1, 1); PG8_STAGE(PG8_SA(1, 0), a3, voffA);
            PG8_BAR; PG8_WAIT_L(0); PG8_MMA(1, 0, At, B0); PG8_BAR; PG8_SCHED;
            PG8_STAGE(PG8_SB(1, 1), b3 + hstep, voffB);
            PG8_WAIT_V(6); PG8_BAR; PG8_MMA(1, 1, At, B1); PG8_BAR;
            }
        }
        if constexpr (ALIGN_EPI) { if (wr == 0) PG8_BAR; }
        if constexpr (!Epi::AFTER_DRAIN) { E(acc, cur, wr, wc, fr, fq); S.done(cur); }
        if (!has_next) break;
#pragma unroll
        for (int a = 0; a < 2; ++a)
#pragma unroll
            for (int b = 0; b < 2; ++b)
#pragma unroll
                for (int m = 0; m < 4; ++m)
#pragma unroll
                    for (int n = 0; n < 2; ++n) acc[a][b][m][n] = (f32x4){0.f, 0.f, 0.f, 0.f};
        cur = nxt; cA = nA; cB = nB; ++ui;
        if constexpr (ALIGN_EPI) { if (wr == 1) PG8_BAR; }
    }
    PG8_WAIT_V(0);
    if constexpr (!ALIGN_EPI) { if (wr == 0) PG8_BAR; }
    PG8_BAR;
    if constexpr (Epi::AFTER_DRAIN) { E.fused(acc, cur, wr, wc, fr, fq, lds, wid, lane); S.done(cur); }
#undef PG8_SA
#undef PG8_SB
#undef PG8_STAGE
#undef PG8_LDA
#undef PG8_LDB
#undef PG8_MMA
#undef PG8_WAIT_V
#undef PG8_WAIT_L
#undef PG8_BAR
#undef PG8_SCHED
}
}
namespace mk {
using pg8::bf16_t; using pg8::f32x4; using pg8::u32x4; using pg8::bf16x8; using pg8::Unit;
#define LAS __attribute__((address_space(3)))
typedef float f32x16 __attribute__((ext_vector_type(16)));
typedef unsigned u32x2 __attribute__((ext_vector_type(2)));
typedef float f32x2 __attribute__((ext_vector_type(2)));
typedef short v4i16_t __attribute__((ext_vector_type(4)));

constexpr int DM = 1024, SEQ = 4096;
constexpr int RP = 32768;
constexpr int RS0 = RP, RS1 = RP + 128;
constexpr int RM0 = RS1, RM1 = RM0 + 16;
constexpr int R = 33024;
constexpr int RC = 8192, RX = R + RC;
constexpr int KPR = 64 + SEQ;
constexpr int KSR = 64 + 1024 + 64;
constexpr int KS0 = 8 * KPR;
constexpr int MT = KS0 + 8 * KSR;
constexpr int TK = MT + 64;
constexpr int NIN = 6176, NINP = 6400, DFF = 2816, DFF2 = 5632, ZRW = 1056;
constexpr float EPS = 1e-6f;
constexpr float QS_A = 0.18033688011112042f, QS_B = 0.14724444602590306f, LOG2E = 1.4426950408889634f;

constexpr size_t O_YP = 0, O_YS = O_YP + (size_t)RP * DM, O_AKP = O_YS + (size_t)128 * DM, O_AKS = O_AKP + (size_t)4 * 8 * 4112 * 1024,
    O_AVP = O_AKS + (size_t)4 * 8 * 16 * 1024, O_AVS = O_AVP + (size_t)4 * 8 * 4112 * 1024, O_CKP = O_AVS + (size_t)4 * 8 * 16 * 1024,
    O_CKS = O_CKP + (size_t)4 * 8 * 4112 * 256, O_KRP = O_CKS + (size_t)4 * 8 * 16 * 256, O_KRS = O_KRP + (size_t)4 * 8 * 4112 * 32,
    O_CVP = O_KRS + (size_t)4 * 8 * 16 * 32, O_CVS = O_CVP + (size_t)4 * 8 * 2 * 5632, O_END = O_CVS + (size_t)4 * 8 * 2 * 5632;
static_assert(O_END == 342982656, "output size");

constexpr size_t WO_IN = 0, WO_UQ = WO_IN + (size_t)NINP * 1024, WO_UKV = WO_UQ + (size_t)768 * 768, WO_A = WO_UKV + (size_t)1024 * 256,
    WO_B = WO_A + (size_t)1024 * 1024, WO_O = WO_B + (size_t)1024 * 512, WO_UP = WO_O + (size_t)1024 * 1024, WO_D = WO_UP + (size_t)DFF2 * 1024,
    WL = WO_D + (size_t)1024 * DFF;

constexpr size_t al256(size_t x) { return (x + 255) & ~(size_t)255; }
constexpr size_t W_H = 0;
constexpr size_t W_XN = al256(W_H + (size_t)R * 1024 * 4);
constexpr size_t W_WT = al256(W_XN + (size_t)R * 1024 * 2);
constexpr size_t W_QA = al256(W_WT + WL * 4 * 2);
constexpr size_t W_KA = al256(W_QA + (size_t)R * 1024 * 2);
constexpr size_t W_VA = al256(W_KA + (size_t)TK * 1024 * 2);
constexpr size_t W_GA = al256(W_VA + (size_t)TK * 1024 * 2);
constexpr size_t W_GB = al256(W_GA + (size_t)R * 1024 * 2);
constexpr size_t W_ZR = al256(W_GB + (size_t)R * 1024 * 2);
constexpr size_t W_CQN = al256(W_ZR + (size_t)R * ZRW * 4);
constexpr size_t W_CKVA = al256(W_CQN + (size_t)R * 768 * 2);
constexpr size_t W_QM = al256(W_CKVA + (size_t)RX * 256 * 2);
constexpr size_t W_KM = al256(W_QM + (size_t)R * 768 * 2);
constexpr size_t W_VM = al256(W_KM + (size_t)TK * 768 * 2);
constexpr size_t W_OA = al256(W_VM + (size_t)TK * 512 * 2);
constexpr size_t W_OB = al256(W_OA + (size_t)R * 1024 * 2);
constexpr size_t W_T1 = al256(W_OB + (size_t)R * 512 * 2);
constexpr size_t W_MM = al256(W_T1 + (size_t)R * 1024 * 4);
constexpr size_t W_U = al256(W_MM + (size_t)R * 1024 * 2);
constexpr size_t W_ACT = al256(W_U + (size_t)R * DFF2 * 2);
constexpr size_t W_LUT = al256(W_ACT + (size_t)R * DFF * 2);
constexpr size_t W_LAM = al256(W_LUT + 8 * 192 * 4);
constexpr size_t W_RT = al256(W_LAM + 64);
constexpr size_t W_PART = al256(W_RT + (size_t)4128 * 16 * 8);
constexpr size_t W_BAR = al256(W_PART + (size_t)11 * 256 * 1024 * 4);
constexpr size_t W_END = al256(W_BAR + 16384);

struct Params { const float* in[26]; float* out; unsigned char* ws; };
typedef const Params __attribute__((address_space(4)))* KP;

__device__ const float ROPE_INV[16] = {1.f, 0.562341332f, 0.316227764f, 0.177827939f, 0.100000001f, 0.0562341325f, 0.0316227749f, 0.0177827943f,
    0.00999999978f, 0.00562341325f, 0.00316227763f, 0.00177827943f, 0.00100000005f, 0.000562341302f, 0.000316227757f, 0.00017782794f};

__device__ __forceinline__ int tid_fresh() { int t = threadIdx.x; asm volatile("" : "+v"(t)); return t; }
__device__ __forceinline__ float shx(float v, int mask, int lane) { return __int_as_float(__builtin_amdgcn_ds_bpermute((lane ^ mask) << 2, __float_as_int(v))); }
__device__ __forceinline__ float wave_sum(float v, int lane) {
#pragma unroll
    for (int o = 1; o < 64; o <<= 1) v += shx(v, o, lane);
    return v;
}
__device__ __forceinline__ unsigned pk2(float lo, float hi) { return pg8::cvt_pk_bf16(lo, hi); }
__device__ __forceinline__ u32x2 pk4(f32x4 v) { u32x2 w; w.x = pk2(v[0], v[1]); w.y = pk2(v[2], v[3]); return w; }
__device__ __forceinline__ float bf2f(unsigned short b) { return __uint_as_float((unsigned)b << 16); }
__device__ __forceinline__ float sigmoidf_(float z) { return 1.f / (1.f + __expf(-z)); }
__device__ __forceinline__ f32x4 ldbf4(const bf16_t* p) { const u32x2 w = *(const u32x2*)p; f32x4 v; v[0] = __uint_as_float(w.x << 16); v[1] = __uint_as_float(w.x & 0xffff0000u); v[2] = __uint_as_float(w.y << 16); v[3] = __uint_as_float(w.y & 0xffff0000u); return v; }
#define LDS_WAIT() asm volatile("s_waitcnt lgkmcnt(0)" ::: "memory")

#define XB_TMO      128
#define XB_XCNT(j)  (256  + 64 * (j))
#define XB_XSUB(j)  (1280 + 64 * (j))
#define XB_XGEN(j)  (2304 + 64 * (j))
#define XB_TOP      3328
#define XB_TOPGEN   3392
#define XCD_BAR_WORDS 3456
#define XB_SPIN_CAP (1u << 18)

__device__ __forceinline__ unsigned xb_ld(unsigned* p)              { return __hip_atomic_load(p, __ATOMIC_RELAXED, __HIP_MEMORY_SCOPE_AGENT); }
__device__ __forceinline__ unsigned xb_add(unsigned* p, unsigned v) { return __hip_atomic_fetch_add(p, v, __ATOMIC_RELAXED, __HIP_MEMORY_SCOPE_AGENT); }
__device__ __forceinline__ unsigned xb_xcc_id() { return (unsigned)__builtin_amdgcn_s_getreg((3 << 11) | 20) & 0xFu; }
#define XB_SPIN(cond, bar) do { unsigned _sp = 0; while (cond) { __builtin_amdgcn_s_sleep(1); \
    if ((++_sp & 255u) == 0u) { if (xb_ld(&(bar)[XB_TMO])) break; if (_sp > XB_SPIN_CAP) { atomicAdd(&(bar)[XB_TMO], 1u); break; } } } } while (0)

struct XcdBarrier {
    unsigned* bar; unsigned x;
    volatile LAS unsigned* st;
};

__device__ __forceinline__ XcdBarrier xcd_barrier_post(unsigned* bar, volatile LAS unsigned* st) {
    XcdBarrier b; b.bar = bar; b.x = xb_xcc_id(); b.st = st;
    if (threadIdx.x == 0) (void)xb_add(&bar[XB_XCNT(b.x)], 1u);
    return b;
}
__device__ __forceinline__ void xcd_barrier_complete(unsigned* bar, unsigned x, unsigned& nloc, unsigned& nx) {
    const unsigned G = gridDim.x * gridDim.y * gridDim.z;
    unsigned sum, cnt, mine, sp = 0u;
    for (;;) {
        sum = 0u; cnt = 0u; mine = 0u;
#pragma unroll
        for (unsigned j = 0; j < 16; ++j) { const unsigned c = xb_ld(&bar[XB_XCNT(j)]); sum += c; cnt += (c > 0u) ? 1u : 0u; mine = (j == x) ? c : mine; }
        if (sum == G) break;
        __builtin_amdgcn_s_sleep(1);
        if ((++sp & 255u) == 0u) { if (xb_ld(&bar[XB_TMO])) break; if (sp > XB_SPIN_CAP) { atomicAdd(&bar[XB_TMO], 1u); break; } }
    }
    nloc = mine > 0u ? mine : 1u; nx = cnt > 0u ? cnt : 1u;
}

__device__ __forceinline__ void xcd_barrier(const XcdBarrier& b) {
    asm volatile("s_waitcnt vmcnt(0)" ::: "memory");
    __syncthreads();
    if (threadIdx.x == 0) {
        unsigned* bar = b.bar;
        __builtin_amdgcn_s_waitcnt(0);
        unsigned nloc = b.st[0], nx = b.st[1];
        if (nloc == 0u) { xcd_barrier_complete(bar, b.x, nloc, nx); b.st[0] = nloc; b.st[1] = nx; }
        const unsigned old = xb_add(&bar[XB_XSUB(b.x)], 1u);
        const unsigned gen = old / nloc;
        if (old + 1u == (gen + 1u) * nloc) {
            __builtin_amdgcn_fence(__ATOMIC_RELEASE, "agent");
            asm volatile("s_waitcnt vmcnt(0)" ::: "memory");
            const unsigned og = xb_add(&bar[XB_TOP], 1u);
            const unsigned tg = og / nx;
            if (og + 1u == (tg + 1u) * nx) xb_add(&bar[XB_TOPGEN], 1u);
            else XB_SPIN(xb_ld(&bar[XB_TOPGEN]) == tg, bar);
            __builtin_amdgcn_fence(__ATOMIC_ACQUIRE, "agent");
            xb_add(&bar[XB_XGEN(b.x)], 1u);
            asm volatile("s_waitcnt vmcnt(0)" ::: "memory");
        } else {
            XB_SPIN(xb_ld(&bar[XB_XGEN(b.x)]) == gen, bar);
            __builtin_amdgcn_fence(__ATOMIC_ACQUIRE, "agent");
            asm volatile("s_waitcnt vmcnt(0)" ::: "memory");
        }
    }
    __syncthreads();
}


struct EpiIn {
    static constexpr bool PERM = false, AFTER_DRAIN = false;
    bf16_t *QA, *KA, *VA, *GA, *GB; float* ZR; float *akp, *aks, *avp, *avs;
    bf16_t* CQ;
    __device__ __forceinline__ void operator()(const f32x4 (&acc)[2][2][4][2], const Unit& u, int wr, int wc, int fr, int fq) const {
        const int pn = u.pn, pm = u.pm, lr0 = wr * 64 + fr, lc0 = wc * 32 + 4 * fq;
        if (pn < 4) {
#pragma unroll
            for (int ai = 0; ai < 2; ++ai)
#pragma unroll
                for (int m = 0; m < 4; ++m) { bf16_t* rp = QA + (size_t)(pm * 256 + ai * 128 + m * 16 + lr0) * 1024 + pn * 256 + lc0;
#pragma unroll
                    for (int bj = 0; bj < 2; ++bj)
#pragma unroll
                        for (int n = 0; n < 2; ++n) *(u32x2*)(rp + bj * 128 + n * 16) = pk4(acc[ai][bj][m][n] * QS_A); }
        } else if (pn < 12) {
            const bool isv = pn >= 8; bf16_t* KV = isv ? VA : KA; float* op = isv ? avp : akp; float* os = isv ? avs : aks;
            const int c0 = (pn - (isv ? 8 : 4)) * 256 + lc0;
            if (pm < 128) {
                const int b1 = (pm >> 4) + 1;
#pragma unroll
                for (int ai = 0; ai < 2; ++ai)
#pragma unroll
                    for (int m = 0; m < 4; ++m) { const int r = pm * 256 + ai * 128 + m * 16 + lr0;
                        bf16_t* kp = KV + (size_t)(r + 64 * b1) * 1024 + c0; float* fp = op + (size_t)(r + 16 * b1) * 1024 + c0;
#pragma unroll
                        for (int bj = 0; bj < 2; ++bj)
#pragma unroll
                            for (int n = 0; n < 2; ++n) { const f32x4 v = acc[ai][bj][m][n]; *(u32x2*)(kp + bj * 128 + n * 16) = pk4(v); *(f32x4*)(fp + bj * 128 + n * 16) = v; } }
            } else {
#pragma unroll
                for (int m = 0; m < 4; ++m) { const int lr = m * 16 + lr0;
                    bf16_t* kp = KV + (size_t)(KS0 + (m + 4 * wr) * KSR + 1088 + fr) * 1024 + c0; float* fp = os + (size_t)lr * 1024 + c0;
#pragma unroll
                    for (int bj = 0; bj < 2; ++bj)
#pragma unroll
                        for (int n = 0; n < 2; ++n) { const f32x4 v = acc[0][bj][m][n]; *(u32x2*)(kp + bj * 128 + n * 16) = pk4(v); *(f32x4*)(fp + bj * 128 + n * 16) = v; } }
                if (wr == 0) {
                    { bf16_t* kp = KV + (size_t)(MT + fr) * 1024 + c0;
#pragma unroll
                      for (int bj = 0; bj < 2; ++bj)
#pragma unroll
                          for (int n = 0; n < 2; ++n) *(u32x2*)(kp + bj * 128 + n * 16) = pk4(acc[1][bj][0][n]); }
#pragma unroll 1
                    for (int bb = 0; bb < 8; ++bb) { float* fp = op + (size_t)(bb * 4112 + fr) * 1024 + c0;
#pragma unroll
                        for (int bj = 0; bj < 2; ++bj)
#pragma unroll
                            for (int n = 0; n < 2; ++n) *(f32x4*)(fp + bj * 128 + n * 16) = acc[1][bj][0][n]; }
                }
            }
        } else if (pn < 15) {
            const int c0 = (pn - 12) * 256 + lc0;
#pragma unroll
            for (int ai = 0; ai < 2; ++ai)
#pragma unroll
                for (int m = 0; m < 4; ++m) { bf16_t* rp = CQ + (size_t)(pm * 256 + ai * 128 + m * 16 + lr0) * 768 + c0;
#pragma unroll
                    for (int bj = 0; bj < 2; ++bj)
#pragma unroll
                        for (int n = 0; n < 2; ++n) *(u32x2*)(rp + bj * 128 + n * 16) = pk4(acc[ai][bj][m][n]); }
        } else if (pn == 23) {
            const int c0 = 768 + lc0;
#pragma unroll
            for (int ai = 0; ai < 2; ++ai)
#pragma unroll
                for (int m = 0; m < 4; ++m) { float* rp = ZR + (size_t)(pm * 256 + ai * 128 + m * 16 + lr0) * ZRW + c0;
#pragma unroll
                    for (int bj = 0; bj < 2; ++bj)
#pragma unroll
                        for (int n = 0; n < 2; ++n) *(f32x4*)(rp + bj * 128 + n * 16) = acc[ai][bj][m][n]; }
        } else if (pn < 23) {
            const bool isb = pn >= 19; bf16_t* G = isb ? GB : GA; const int c0 = (pn - (isb ? 19 : 15)) * 256 + lc0;
#pragma unroll
            for (int ai = 0; ai < 2; ++ai)
#pragma unroll
                for (int m = 0; m < 4; ++m) { bf16_t* rp = G + (size_t)(pm * 256 + ai * 128 + m * 16 + lr0) * 1024 + c0;
#pragma unroll
                    for (int bj = 0; bj < 2; ++bj)
#pragma unroll
                        for (int n = 0; n < 2; ++n) { const f32x4 z = acc[ai][bj][m][n]; f32x4 sg; sg[0] = sigmoidf_(z[0]); sg[1] = sigmoidf_(z[1]); sg[2] = sigmoidf_(z[2]); sg[3] = sigmoidf_(z[3]);
                            *(u32x2*)(rp + bj * 128 + n * 16) = pk4(sg); } }
        } else {
            if (wc == 0) {
#pragma unroll
                for (int ai = 0; ai < 2; ++ai)
#pragma unroll
                    for (int m = 0; m < 4; ++m) { float* rp = ZR + (size_t)(pm * 256 + ai * 128 + m * 16 + lr0) * ZRW + 1024 + 4 * fq;
#pragma unroll
                        for (int n = 0; n < 2; ++n) *(f32x4*)(rp + n * 16) = acc[ai][0][m][n]; }
            }
        }
    }
};

__device__ __forceinline__ int row_pos(int r) { return r < RP ? (r & 4095) : (r < RS1 ? 1024 + ((r - RS0) & 15) : (r < RM1 ? r - RM0 - 16 : 0)); }

struct EpiUq {
    static constexpr bool PERM = false, AFTER_DRAIN = false;
    bf16_t* QM; const float* RT;
    __device__ __forceinline__ void operator()(const f32x4 (&acc)[2][2][4][2], const Unit& u, int wr, int wc, int fr, int fq) const {
        const int pn = u.pn, pm = u.pm, lr0 = wr * 64 + fr, lc0 = wc * 32 + 4 * fq;
#pragma unroll
        for (int bj = 0; bj < 2; ++bj) {
            const int blk = 8 * pn + 4 * bj + wc; const bool rp = (blk % 3) == 2;
#pragma unroll
            for (int ai = 0; ai < 2; ++ai)
#pragma unroll
                for (int m = 0; m < 4; ++m) { const int r = pm * 256 + ai * 128 + m * 16 + lr0;
                    f32x4 a = acc[ai][bj][m][0], b = acc[ai][bj][m][1];
                    if (rp) { const int pos = row_pos(r); const f32x4* cs = (const f32x4*)(RT + ((size_t)(pos + 16) * 16 + 4 * fq) * 2);
                        const f32x4 c01 = cs[0], c23 = cs[1]; f32x4 na, nb;
                        na[0] = a[0] * c01[0] - b[0] * c01[1]; nb[0] = a[0] * c01[1] + b[0] * c01[0];
                        na[1] = a[1] * c01[2] - b[1] * c01[3]; nb[1] = a[1] * c01[3] + b[1] * c01[2];
                        na[2] = a[2] * c23[0] - b[2] * c23[1]; nb[2] = a[2] * c23[1] + b[2] * c23[0];
                        na[3] = a[3] * c23[2] - b[3] * c23[3]; nb[3] = a[3] * c23[3] + b[3] * c23[2];
                        a = na; b = nb; }
                    bf16_t* op = QM + (size_t)r * 768 + pn * 256 + bj * 128 + lc0;
                    *(u32x2*)(op) = pk4(a * QS_B); *(u32x2*)(op + 16) = pk4(b * QS_B); }
        }
    }
};

struct EpiKv {
    static constexpr bool PERM = true, AFTER_DRAIN = false;
    bf16_t *KM, *VM;
    __device__ __forceinline__ void operator()(const f32x4 (&acc)[2][2][4][2], const Unit& u, int wr, int wc, int fr, int fq) const {
        const int pn = u.pn, pm = u.pm, lr0 = wr * 64 + fr;
        const bool isk = wc < 2; const int pitch = isk ? 768 : 512, hstep = isk ? 96 : 64;
        bf16_t* base = (isk ? KM + wc * 32 : VM + (wc - 2) * 32) + 2 * pn * hstep + 8 * fq;
#define KV_ST(P, A0, A1) do { u32x4 w_; w_.x = pk2((A0)[0], (A0)[1]); w_.y = pk2((A0)[2], (A0)[3]); w_.z = pk2((A1)[0], (A1)[1]); w_.w = pk2((A1)[2], (A1)[3]); *(u32x4*)(P) = w_; } while (0)
        if (pm != 128) {
            const int kb = pm < 128 ? pm * 256 + 64 * ((pm >> 4) + 1) : KS0 + ((pm - 129) >> 2) * KSR + 64 + ((pm - 129) & 3) * 256;
#pragma unroll
            for (int ai = 0; ai < 2; ++ai)
#pragma unroll
                for (int m = 0; m < 4; ++m) { bf16_t* rp = base + (size_t)(kb + ai * 128 + m * 16 + lr0) * pitch;
#pragma unroll
                    for (int bj = 0; bj < 2; ++bj) KV_ST(rp + bj * hstep, acc[ai][bj][m][0], acc[ai][bj][m][1]); }
        } else {
#pragma unroll
            for (int m = 0; m < 4; ++m) { bf16_t* rp = base + (size_t)(KS0 + (m + 4 * wr) * KSR + 1088 + fr) * pitch;
#pragma unroll
                for (int bj = 0; bj < 2; ++bj) KV_ST(rp + bj * hstep, acc[0][bj][m][0], acc[0][bj][m][1]); }
            if (wr == 0) { bf16_t* rp = base + (size_t)(MT + fr) * pitch;
#pragma unroll
                for (int bj = 0; bj < 2; ++bj) KV_ST(rp + bj * hstep, acc[1][bj][0][0], acc[1][bj][0][1]); }
        }
#undef KV_ST
    }
};

struct EpiBrA {
    static constexpr bool PERM = false, AFTER_DRAIN = false;
    const bf16_t* GA; bf16_t* T1;
    __device__ __forceinline__ void operator()(const f32x4 (&acc)[2][2][4][2], const Unit& u, int wr, int wc, int fr, int fq) const {
        const int lr0 = wr * 64 + fr, c0 = u.pn * 256 + wc * 32 + 4 * fq;
#pragma unroll
        for (int ai = 0; ai < 2; ++ai)
#pragma unroll
            for (int m = 0; m < 4; ++m) { const size_t ro = (size_t)(u.pm * 256 + ai * 128 + m * 16 + lr0) * 1024 + c0;
#pragma unroll
                for (int bj = 0; bj < 2; ++bj)
#pragma unroll
                    for (int n = 0; n < 2; ++n) { const f32x4 g = ldbf4(GA + ro + bj * 128 + n * 16); *(u32x2*)(T1 + ro + bj * 128 + n * 16) = pk4(acc[ai][bj][m][n] * g); } }
    }
};
struct EpiBrB {
    static constexpr bool PERM = false, AFTER_DRAIN = false;
    const bf16_t* GB; const bf16_t* T1; bf16_t* MM;
    __device__ __forceinline__ void operator()(const f32x4 (&acc)[2][2][4][2], const Unit& u, int wr, int wc, int fr, int fq) const {
        const int lr0 = wr * 64 + fr, c0 = u.pn * 256 + wc * 32 + 4 * fq;
#pragma unroll
        for (int ai = 0; ai < 2; ++ai)
#pragma unroll
            for (int m = 0; m < 4; ++m) { const size_t ro = (size_t)(u.pm * 256 + ai * 128 + m * 16 + lr0) * 1024 + c0;
#pragma unroll
                for (int bj = 0; bj < 2; ++bj)
#pragma unroll
                    for (int n = 0; n < 2; ++n) { const f32x4 g = ldbf4(GB + ro + bj * 128 + n * 16), t = ldbf4(T1 + ro + bj * 128 + n * 16); *(u32x2*)(MM + ro + bj * 128 + n * 16) = pk4(t + acc[ai][bj][m][n] * g); } }
    }
};
struct EpiRes {
    static constexpr bool PERM = false, AFTER_DRAIN = false;
    bf16_t* H; int ntf; float* PART;
    __device__ __forceinline__ void operator()(const f32x4 (&acc)[2][2][4][2], const Unit& u, int wr, int wc, int fr, int fq) const {
        const int lr0 = wr * 64 + fr, c0 = u.pn * 256 + wc * 32 + 4 * fq;
        if (u.nt == ntf) {
#pragma unroll
            for (int ai = 0; ai < 2; ++ai)
#pragma unroll
                for (int m = 0; m < 4; ++m) { bf16_t* rp = H + (size_t)(u.pm * 256 + ai * 128 + m * 16 + lr0) * 1024 + c0;
#pragma unroll
                    for (int bj = 0; bj < 2; ++bj)
#pragma unroll
                        for (int n = 0; n < 2; ++n) { bf16_t* q = rp + bj * 128 + n * 16; *(u32x2*)q = pk4(ldbf4(q) + acc[ai][bj][m][n]); } }
        } else {
            const int ks = u.k0 / (u.nt * 64);
#pragma unroll
            for (int ai = 0; ai < 2; ++ai)
#pragma unroll
                for (int m = 0; m < 4; ++m) { float* rp = PART + ((size_t)ks * 256 + ai * 128 + m * 16 + lr0) * 1024 + c0;
#pragma unroll
                    for (int bj = 0; bj < 2; ++bj)
#pragma unroll
                        for (int n = 0; n < 2; ++n) *(f32x4*)(rp + bj * 128 + n * 16) = acc[ai][bj][m][n]; }
        }
    }
};
struct EpiUp {
    static constexpr bool PERM = true, AFTER_DRAIN = false;
    bf16_t* U; float *cvp, *cvs;
    __device__ __forceinline__ void operator()(const f32x4 (&acc)[2][2][4][2], const Unit& u, int wr, int wc, int fr, int fq) const {
        const int pm = u.pm, lr0 = wr * 64 + fr, c0 = u.pn * 256 + wc * 32 + 8 * fq;
#pragma unroll
        for (int ai = 0; ai < 2; ++ai)
#pragma unroll
            for (int m = 0; m < 4; ++m) { const int lr = ai * 128 + m * 16 + lr0; bf16_t* rp = U + (size_t)(pm * 256 + lr) * DFF2 + c0;
                float* cv = nullptr;
                if (pm < 128) { if ((pm & 15) == 15 && lr >= 254) cv = cvp + (size_t)((pm >> 4) * 2 + (lr - 254)) * DFF2; }
                else if (lr < 128 && (lr & 15) >= 14) cv = cvs + (size_t)((lr >> 4) * 2 + ((lr & 15) - 14)) * DFF2;
#pragma unroll
                for (int bj = 0; bj < 2; ++bj) { const f32x4 v0 = acc[ai][bj][m][0], v1 = acc[ai][bj][m][1]; u32x4 w; w.x = pk2(v0[0], v0[1]); w.y = pk2(v0[2], v0[3]); w.z = pk2(v1[0], v1[1]); w.w = pk2(v1[2], v1[3]);
                    *(u32x4*)(rp + bj * 128) = w;
                    if (cv) { *(f32x4*)(cv + c0 + bj * 128) = v0; *(f32x4*)(cv + c0 + bj * 128 + 4) = v1; } } }
    }
};
__device__ __forceinline__ void transpose_item(const float* W, int K, int N, bf16_t* WT, int k0, int n0, int drow0, LAS float* scr, int lane) {
#pragma unroll 8
    for (int i = 0; i < 32; ++i) { const int kk = 2 * i + (lane >> 5); scr[kk * 33 + (lane & 31)] = W[(size_t)(k0 + kk) * N + n0 + (lane & 31)]; }
    LDS_WAIT();
    const int c = lane & 7;
#pragma unroll
    for (int j = 0; j < 4; ++j) { const int n = (lane >> 3) + 8 * j; const LAS float* s = scr + (8 * c) * 33 + n;
        u32x4 o; o.x = pk2(s[0 * 33], s[1 * 33]); o.y = pk2(s[2 * 33], s[3 * 33]); o.z = pk2(s[4 * 33], s[5 * 33]); o.w = pk2(s[6 * 33], s[7 * 33]);
        *(u32x4*)(WT + (size_t)(drow0 + n) * K + k0 + 8 * c) = o; }
    LDS_WAIT();
}
__device__ __forceinline__ void conv_row_bf16(const float* src, bf16_t* dst, int lane) {
#pragma unroll
    for (int j = 0; j < 4; ++j) { const f32x4 v = ((const f32x4*)src)[lane + 64 * j]; ((u32x2*)dst)[lane + 64 * j] = pk4(v); }
}

__device__ __forceinline__ void phase_prologue(KP p, LAS unsigned char* lds, int gw, int NGW, int wave, int lane) {
    unsigned char* ws = p->ws;
    LAS float* scr = (LAS float*)(lds + wave * 8448);
    constexpr int I_IN = 16 * 193, I_UQ = 12 * 24, I_UKV = 4 * 32, I_A = 16 * 32, I_B = 8 * 32, I_O = 16 * 32, I_UP = 16 * 176, I_D = 44 * 32;
    constexpr int I_L = I_IN + I_UQ + I_UKV + I_A + I_B + I_O + I_UP + I_D;
    for (int it = gw; it < 4 * I_L; it += NGW) {
        const int l = it / I_L; int r = it - l * I_L; bf16_t* WT = (bf16_t*)(ws + W_WT) + (size_t)l * WL;
        if (r < I_IN) { const int kb = r / 193, nb = r - kb * 193, n0 = nb * 32; const int d0 = n0 < 3840 ? n0 : (n0 < 4128 ? 5888 + (n0 - 3840) : n0 - 288);
            transpose_item(p->in[10] + (size_t)l * 1024 * NIN, 1024, NIN, WT + WO_IN, kb * 64, n0, d0, scr, lane); continue; } r -= I_IN;
        if (r < I_UQ) { const int kb = r / 24, nb = r - kb * 24; transpose_item(p->in[14] + (size_t)l * 768 * 768, 768, 768, WT + WO_UQ, kb * 64, nb * 32, nb * 32, scr, lane); continue; } r -= I_UQ;
        if (r < I_UKV) { const int kb = r / 32, nb = r & 31; transpose_item(p->in[16] + (size_t)l * 256 * 1024, 256, 1024, WT + WO_UKV, kb * 64, nb * 32, nb * 32, scr, lane); continue; } r -= I_UKV;
        if (r < I_A) { const int kb = r / 32, nb = r & 31; transpose_item(p->in[17] + (size_t)l * 1024 * 1024, 1024, 1024, WT + WO_A, kb * 64, nb * 32, nb * 32, scr, lane); continue; } r -= I_A;
        if (r < I_B) { const int kb = r / 32, nb = r & 31; transpose_item(p->in[18] + (size_t)l * 512 * 1024, 512, 1024, WT + WO_B, kb * 64, nb * 32, nb * 32, scr, lane); continue; } r -= I_B;
        if (r < I_O) { const int kb = r / 32, nb = r & 31; transpose_item(p->in[19] + (size_t)l * 1024 * 1024, 1024, 1024, WT + WO_O, kb * 64, nb * 32, nb * 32, scr, lane); continue; } r -= I_O;
        if (r < I_UP) { const int kb = r / 176, nb = r - kb * 176; transpose_item(p->in[21] + (size_t)l * 1024 * DFF2, 1024, DFF2, WT + WO_UP, kb * 64, nb * 32, nb * 32, scr, lane); continue; } r -= I_UP;
        { const int kb = r / 32, nb = r & 31; transpose_item(p->in[24] + (size_t)l * DFF * 1024, DFF, 1024, WT + WO_D, kb * 64, nb * 32, nb * 32, scr, lane); }
    }
    const int gt = gw * 64 + lane, NGT = NGW * 64;
    float* LUT = (float*)(ws + W_LUT); float* LAM = (float*)(ws + W_LAM); float* RT = (float*)(ws + W_RT);
    for (int i = gt; i < 8 * 192; i += NGT) { const int h = i / 192, rel = (i - h * 192) - 128; const int n = rel < 0 ? -rel : rel; int bk;
        if (n < 8) bk = n; else { const int k = (31 - __clz(n * n)) - 6; bk = 8 + k; if (bk > 15) bk = 15; }
        if (rel > 0) bk += 16;
        LUT[i] = p->in[8][bk * 8 + h] * LOG2E; }
    if (gt < 4) { const float* al = p->in[11] + gt * 256; float s1 = 0.f, s2 = 0.f; for (int i = 0; i < 64; ++i) { s1 += al[i] * al[64 + i]; s2 += al[128 + i] * al[192 + i]; }
        LAM[gt] = expf(s1) - expf(s2) + (0.8f - 0.6f * expf(-0.3f * (float)gt)); }
    for (int i = gt; i < 4128 * 16; i += NGT) { const int pi = i >> 4, k = i & 15; const float ang = (float)(pi - 16) * ROPE_INV[k];
        const double a = (double)ang * 0.15915494309189535; const double fr = a - rint(a); const float f = (float)fr * 6.283185307179586f;
        RT[2 * i] = cosf(f); RT[2 * i + 1] = sinf(f); }
}

__device__ __forceinline__ void phase_norm(KP p, int l, const float* g, int gw, int NGW, int lane, bool first, int nparts) {
    unsigned char* ws = p->ws; bf16_t* H = (bf16_t*)(ws + W_H); bf16_t* XN = (bf16_t*)(ws + W_XN); const float* PART = (const float*)(ws + W_PART);
    f32x4 gv[4];
#pragma unroll
    for (int j = 0; j < 4; ++j) gv[j] = ((const f32x4*)g)[lane + 64 * j];
    for (int r = gw; r < RM1; r += NGW) {
        f32x4 v[4]; float ss = 0.f;
        if (first) { const float* src = r < RP ? p->in[0] + (size_t)r * 1024 : (r < RS1 ? p->in[1] + (size_t)(r - RS0) * 1024 : p->in[7] + (size_t)(r - RM0) * 1024);
#pragma unroll
            for (int j = 0; j < 4; ++j) v[j] = ((const f32x4*)src)[lane + 64 * j]; }
        else {
#pragma unroll
            for (int j = 0; j < 4; ++j) v[j] = ldbf4(H + (size_t)r * 1024 + (lane + 64 * j) * 4); }
        const bool fold = (r >= RP) && nparts > 0;
        if (fold) {
#pragma unroll 1
            for (int k = 0; k < nparts; ++k) { const f32x4* pp = (const f32x4*)(PART + ((size_t)k * 256 + (r - RP)) * 1024);
#pragma unroll
                for (int j = 0; j < 4; ++j) v[j] = v[j] + pp[lane + 64 * j]; } }
#pragma unroll
        for (int j = 0; j < 4; ++j) ss += (v[j][0] * v[j][0] + v[j][1] * v[j][1]) + (v[j][2] * v[j][2] + v[j][3] * v[j][3]);
        const float rstd = 1.0f / sqrtf(wave_sum(ss, lane) * (1.f / 1024.f) + EPS);
#pragma unroll
        for (int j = 0; j < 4; ++j) { if (first || fold) ((u32x2*)(H + (size_t)r * 1024))[lane + 64 * j] = pk4(v[j]);
            ((u32x2*)(XN + (size_t)r * 1024))[lane + 64 * j] = pk4(v[j] * rstd * gv[j]); }
    }
}
__device__ __forceinline__ void phase_cache_conv(KP p, int l, int gw, int NGW, int lane) {
    unsigned char* ws = p->ws; bf16_t* KA = (bf16_t*)(ws + W_KA); bf16_t* VA = (bf16_t*)(ws + W_VA);
    for (int i = gw; i < 16384; i += NGW) { const int which = i >> 13, rr = i & 8191, b = rr >> 10, pp = rr & 1023;
        const float* src = p->in[which ? 3 : 2] + ((size_t)(l * 8 + b) * 1024 + pp) * 1024;
        conv_row_bf16(src, (which ? VA : KA) + (size_t)(KS0 + b * KSR + 64 + pp) * 1024, lane); }
}
__device__ __forceinline__ void phase_final(KP p, int gw, int NGW, int lane) {
    const bf16_t* H = (const bf16_t*)(p->ws + W_H); const float* g = p->in[25];
    for (int r = gw; r < RS1; r += NGW) {
        const bf16_t* src = H + (size_t)r * 1024; float* dst = p->out + (r < RP ? O_YP + (size_t)r * 1024 : O_YS + (size_t)(r - RS0) * 1024);
        f32x4 v[4]; float ss = 0.f;
#pragma unroll
        for (int j = 0; j < 4; ++j) v[j] = ldbf4(src + (lane + 64 * j) * 4);
        if (r >= RP) {
#pragma unroll 1
            for (int k = 0; k < 11; ++k) { const f32x4* pp = (const f32x4*)((const float*)(p->ws + W_PART) + ((size_t)k * 256 + (r - RP)) * 1024);
#pragma unroll
                for (int j = 0; j < 4; ++j) v[j] = v[j] + pp[lane + 64 * j]; } }
#pragma unroll
        for (int j = 0; j < 4; ++j) ss += (v[j][0] * v[j][0] + v[j][1] * v[j][1]) + (v[j][2] * v[j][2] + v[j][3] * v[j][3]);
        const float rstd = 1.0f / sqrtf(wave_sum(ss, lane) * (1.f / 1024.f) + EPS);
#pragma unroll
        for (int j = 0; j < 4; ++j) ((f32x4*)dst)[lane + 64 * j] = v[j] * rstd * ((const f32x4*)g)[lane + 64 * j];
    }
}

__device__ __forceinline__ void kpe_store(bf16_t* KM, int krow, int lane, unsigned short v1, unsigned short v2) {
    const int i = lane & 15, hs = lane >> 4; bf16_t* rp = KM + (size_t)krow * 768 + 64 + i;
    rp[hs * 96] = v1; rp[hs * 96 + 16] = v2; rp[(hs + 4) * 96] = v1; rp[(hs + 4) * 96 + 16] = v2;
}
__device__ __forceinline__ void phase_mlaprep(KP p, int l, int gw, int NGW, int lane) {
    unsigned char* ws = p->ws; const float* ZR = (const float*)(ws + W_ZR); bf16_t* CQN = (bf16_t*)(ws + W_CQN); bf16_t* CKVA = (bf16_t*)(ws + W_CKVA); bf16_t* KM = (bf16_t*)(ws + W_KM);
    const float* RT = (const float*)(ws + W_RT);
    const float* gq = p->in[13] + l * 768; const float* gkv = p->in[15] + l * 256;
    float* ckp = p->out + O_CKP + (size_t)l * 8 * 4112 * 256; float* cks = p->out + O_CKS + (size_t)l * 128 * 256;
    float* krp = p->out + O_KRP + (size_t)l * 8 * 4112 * 32; float* krs = p->out + O_KRS + (size_t)l * 128 * 32;
    for (int r = gw; r < RM1; r += NGW) {
        const float* z = ZR + (size_t)r * ZRW;
        { f32x4 v[3]; float ss = 0.f; bf16_t* cq = CQN + (size_t)r * 768;
#pragma unroll
          for (int j = 0; j < 3; ++j) { v[j] = ldbf4(cq + (lane + 64 * j) * 4); ss += (v[j][0] * v[j][0] + v[j][1] * v[j][1]) + (v[j][2] * v[j][2] + v[j][3] * v[j][3]); }
          const float rstd = 1.0f / sqrtf(wave_sum(ss, lane) * (1.f / 768.f) + EPS);
#pragma unroll
          for (int j = 0; j < 3; ++j) ((u32x2*)cq)[lane + 64 * j] = pk4(v[j] * rstd * ((const f32x4*)gq)[lane + 64 * j]); }
        { f32x4 v = ((const f32x4*)(z + 768))[lane]; const float ss = (v[0] * v[0] + v[1] * v[1]) + (v[2] * v[2] + v[3] * v[3]);
          const float rstd = 1.0f / sqrtf(wave_sum(ss, lane) * (1.f / 256.f) + EPS);
          v = v * rstd * ((const f32x4*)gkv)[lane];
          ((u32x2*)(CKVA + (size_t)r * 256))[lane] = pk4(v);
          if (r < RP) { const int b = r >> 12, t = r & 4095; ((f32x4*)(ckp + (size_t)(b * 4112 + 16 + t) * 256))[lane] = v; }
          else if (r < RS1) ((f32x4*)(cks + (size_t)(r - RS0) * 256))[lane] = v;
          else { const int j = r - RM0;
#pragma unroll 1
              for (int bb = 0; bb < 8; ++bb) ((f32x4*)(ckp + (size_t)(bb * 4112 + j) * 256))[lane] = v; } }
        { const int i = lane & 15; const float x1 = z[1024 + i], x2 = z[1040 + i]; const int pos = row_pos(r);
          const float c = RT[((size_t)(pos + 16) * 16 + i) * 2], s = RT[((size_t)(pos + 16) * 16 + i) * 2 + 1];
          const float o1 = x1 * c - x2 * s, o2 = x1 * s + x2 * c;
          const unsigned pk = pk2(o1, o2); const unsigned short b1 = (unsigned short)(pk & 0xffffu), b2 = (unsigned short)(pk >> 16);
          if (r < RP) { const int b = r >> 12, t = r & 4095; if (lane < 16) { float* o = krp + (size_t)(b * 4112 + 16 + t) * 32; o[i] = o1; o[16 + i] = o2; } kpe_store(KM, b * KPR + 64 + t, lane, b1, b2); }
          else if (r < RS1) { const int q = r - RS0; if (lane < 16) { float* o = krs + (size_t)q * 32; o[i] = o1; o[16 + i] = o2; } kpe_store(KM, KS0 + (q >> 4) * KSR + 1088 + (q & 15), lane, b1, b2); }
          else { const int j = r - RM0;
#pragma unroll 1
              for (int bb = 0; bb < 8; ++bb) { if (lane < 16) { float* o = krp + (size_t)(bb * 4112 + j) * 32; o[i] = o1; o[16 + i] = o2; } }
              kpe_store(KM, MT + j, lane, b1, b2); } }
    }
    const float* cck = p->in[4] + (size_t)l * RC * 256; const float* ckr = p->in[5] + (size_t)l * RC * 32;
    for (int i = gw; i < RC; i += NGW) {
        const f32x4 v = ((const f32x4*)(cck + (size_t)i * 256))[lane]; ((u32x2*)(CKVA + (size_t)(R + i) * 256))[lane] = pk4(v);
        const int k = lane & 15; const unsigned pk = pk2(ckr[(size_t)i * 32 + k], ckr[(size_t)i * 32 + 16 + k]);
        kpe_store(KM, KS0 + (i >> 10) * KSR + 64 + (i & 1023), lane, (unsigned short)(pk & 0xffffu), (unsigned short)(pk >> 16));
    }
}

__device__ __forceinline__ void phase_conv(KP p, int l, int gw, int NGW, int lane) {
    unsigned char* ws = p->ws; const bf16_t* U = (const bf16_t*)(ws + W_U); bf16_t* ACT = (bf16_t*)(ws + W_ACT);
    const float* cw = p->in[22] + (size_t)l * 3 * DFF2; const float* cb = p->in[23] + (size_t)l * DFF2; const float* st = p->in[6] + (size_t)l * 8 * 2 * DFF2;
    constexpr int NRB = RM1 / 16;
    for (int it = gw; it < NRB * 11; it += NGW) {
        const int rbi = it / 11, sl = it - rbi * 11, rb = NRB - 1 - rbi, r0 = rb * 16, f = sl * 256 + lane * 4;
        const f32x4 wa0 = *(const f32x4*)(cw + f), wa1 = *(const f32x4*)(cw + DFF2 + f), wa2 = *(const f32x4*)(cw + 2 * DFF2 + f), ba = *(const f32x4*)(cb + f);
        const f32x4 wg0 = *(const f32x4*)(cw + DFF + f), wg1 = *(const f32x4*)(cw + DFF2 + DFF + f), wg2 = *(const f32x4*)(cw + 2 * DFF2 + DFF + f), bg = *(const f32x4*)(cb + DFF + f);
        f32x4 a2, a1, g2, g1;
        if (r0 < RP) { if ((r0 & 4095) == 0) { const bf16_t* m0 = U + (size_t)(RM0 + 14) * DFF2; a2 = ldbf4(m0 + f); g2 = ldbf4(m0 + DFF + f); a1 = ldbf4(m0 + DFF2 + f); g1 = ldbf4(m0 + DFF2 + DFF + f); }
                       else { const bf16_t* m0 = U + (size_t)(r0 - 2) * DFF2; a2 = ldbf4(m0 + f); g2 = ldbf4(m0 + DFF + f); a1 = ldbf4(m0 + DFF2 + f); g1 = ldbf4(m0 + DFF2 + DFF + f); } }
        else if (r0 < RS1) { const float* s0 = st + (size_t)((r0 - RS0) >> 4) * 2 * DFF2; a2 = *(const f32x4*)(s0 + f); g2 = *(const f32x4*)(s0 + DFF + f); a1 = *(const f32x4*)(s0 + DFF2 + f); g1 = *(const f32x4*)(s0 + DFF2 + DFF + f); }
        else { a2 = (f32x4){0.f, 0.f, 0.f, 0.f}; a1 = a2; g2 = a2; g1 = a2; }
#pragma unroll 4
        for (int i = 0; i < 16; ++i) { const bf16_t* ur = U + (size_t)(r0 + i) * DFF2; const f32x4 a0 = ldbf4(ur + f), g0 = ldbf4(ur + DFF + f);
            const f32x4 ca = ba + wa0 * a2 + wa1 * a1 + wa2 * a0, cg = bg + wg0 * g2 + wg1 * g1 + wg2 * g0; f32x4 o;
            o[0] = ca[0] * cg[0] / (1.f + __expf(-cg[0])); o[1] = ca[1] * cg[1] / (1.f + __expf(-cg[1])); o[2] = ca[2] * cg[2] / (1.f + __expf(-cg[2])); o[3] = ca[3] * cg[3] / (1.f + __expf(-cg[3]));
            *(u32x2*)(ACT + (size_t)(r0 + i) * DFF + f) = pk4(o);
            a2 = a1; a1 = a0; g2 = g1; g1 = g0; }
    }
}
template <bool DIFF>
__device__ __forceinline__ void attn_unit(LAS unsigned char* lds, const bf16_t* Qg, const bf16_t* Kg, const bf16_t* Vg, bf16_t* Og,
        const int kbase, const int hx, const int NT, const int lastv, const int qrow_w, const int qpos_w, const int nqv, const int nt_w,
        const float* lutg, const float lam, const float oscale, const float* subg) {
    constexpr int DQK = DIFF ? 64 : 96, NS = DQK / 16, NDB = DIFF ? 4 : 2;
    constexpr int KCH = DQK / 4, KROWB = DQK * 4 + 16, VROWB = 320, KTILEB = 64 * KROWB, VTILEB = 64 * VROWB, BUFB = KTILEB + VTILEB, NKC = 64 * KCH / 512;
    constexpr int KP = DIFF ? 1024 : 768, VP = DIFF ? 1024 : 512;
    constexpr int LUT_OFF = 98304;
    const int tid = tid_fresh(), lane = tid & 63, wid = __builtin_amdgcn_readfirstlane(tid >> 6), s = wid >> 2, l32 = lane & 31, hi = lane >> 5;
    const int kcol0 = hx * (2 * DQK), vcol0 = hx * 128, sdv = DIFF ? 0 : s * 64;
    LAS float* lut = (LAS float*)(lds + LUT_OFF);
    u32x4 kst[NKC], vst[2];
#define ATT_GLOAD(t) do { \
    _Pragma("unroll") for (int i_ = 0; i_ < NKC; ++i_) { const int c_ = tid + 512 * i_, row_ = c_ / KCH, cc_ = c_ - row_ * KCH; kst[i_] = *(const u32x4*)(Kg + (size_t)(((t) == 0 ? MT : kbase + (t) * 64) + row_) * KP + kcol0 + cc_ * 8); } \
    _Pragma("unroll") for (int i_ = 0; i_ < 2; ++i_) { const int c_ = tid + 512 * i_, row_ = c_ >> 4, cc_ = c_ & 15; vst[i_] = *(const u32x4*)(Vg + (size_t)(((t) == 0 ? MT : kbase + (t) * 64) + row_) * VP + vcol0 + cc_ * 8); } } while (0)
#define ATT_LSTORE(b) do { \
    _Pragma("unroll") for (int i_ = 0; i_ < NKC; ++i_) { const int c_ = tid + 512 * i_, row_ = c_ / KCH, cc_ = c_ - row_ * KCH; *(LAS u32x4*)(lds + (b) * BUFB + row_ * KROWB + cc_ * 16) = kst[i_]; } \
    _Pragma("unroll") for (int i_ = 0; i_ < 2; ++i_) { const int c_ = tid + 512 * i_, row_ = c_ >> 4, cc_ = c_ & 15; *(LAS u32x4*)(lds + (b) * BUFB + KTILEB + row_ * VROWB + cc_ * 16) = vst[i_]; } } while (0)
    ATT_GLOAD(0);
    if (DIFF) { if (tid < 192) lut[tid] = lutg[hx * 192 + tid] - lutg[hx * 192]; }
    bf16x8 qf[NS];
    { const int qi = l32 < nqv ? l32 : (nqv > 0 ? nqv - 1 : 0);
      const bf16_t* qp = Qg + (size_t)(qrow_w + qi) * KP + (DIFF ? hx * 128 + s * 64 : (hx * 2 + s) * 96) + hi * 8;
#pragma unroll
      for (int st = 0; st < NS; ++st) qf[st] = *(const bf16x8*)(qp + st * 16); }
    f32x16 o[NDB];
#pragma unroll
    for (int db = 0; db < NDB; ++db)
#pragma unroll
        for (int r = 0; r < 16; ++r) o[db][r] = 0.f;
    float mrun = 0.f, lsum = 0.f; f32x16 negm;
#pragma unroll
    for (int r = 0; r < 16; ++r) negm[r] = 0.f;
    ATT_LSTORE(0);
    __syncthreads();
    const int qpos = qpos_w + l32;
    for (int t = 0; t < NT; ++t) {
        const int buf = t & 1;
        if (t + 1 < NT) ATT_GLOAD(t + 1);
        if (t < nt_w) {
            const LAS unsigned char* kb_ = lds + buf * BUFB; const LAS unsigned char* vb_ = kb_ + KTILEB;
            f32x16 pr[2];
            const LAS unsigned char* vbase = vb_ + (4 * hi + ((lane & 15) >> 2)) * VROWB + (sdv + ((lane >> 4) & 1) * 16 + (lane & 3) * 4) * 2;
#define VLOAD(dst, g) do { _Pragma("unroll") for (int db_ = 0; db_ < NDB; ++db_) { const LAS unsigned char* va_ = vbase + ((g) * 16) * VROWB + db_ * 64; \
                const v4i16_t t1_ = __builtin_amdgcn_ds_read_tr16_b64_v4i16((LAS v4i16_t*)va_); const v4i16_t t2_ = __builtin_amdgcn_ds_read_tr16_b64_v4i16((LAS v4i16_t*)(va_ + 8 * VROWB)); \
                dst[db_] = __builtin_shufflevector(t1_, t2_, 0, 1, 2, 3, 4, 5, 6, 7); } } while (0)
#define PVMMA(src, g) do { u32x4 pw_; pw_.x = pk2(pr[(g) >> 1][8 * ((g) & 1) + 0], pr[(g) >> 1][8 * ((g) & 1) + 1]); pw_.y = pk2(pr[(g) >> 1][8 * ((g) & 1) + 2], pr[(g) >> 1][8 * ((g) & 1) + 3]); \
                pw_.z = pk2(pr[(g) >> 1][8 * ((g) & 1) + 4], pr[(g) >> 1][8 * ((g) & 1) + 5]); pw_.w = pk2(pr[(g) >> 1][8 * ((g) & 1) + 6], pr[(g) >> 1][8 * ((g) & 1) + 7]); const bf16x8 pf_ = __builtin_bit_cast(bf16x8, pw_); \
                _Pragma("unroll") for (int db_ = 0; db_ < NDB; ++db_) o[db_] = __builtin_amdgcn_mfma_f32_32x32x16_bf16(src[db_], pf_, o[db_], 0, 0, 0); } while (0)
            bf16x8 vfa[NDB], vfb[NDB];
            {
                bf16x8 kf[2][NS];
#pragma unroll
                for (int kb = 0; kb < 2; ++kb)
#pragma unroll
                    for (int st = 0; st < NS; ++st) kf[kb][st] = *(const LAS bf16x8*)(kb_ + (kb * 32 + l32) * KROWB + (s * DQK + st * 16 + hi * 8) * 2);
                VLOAD(vfa, 0);
                __builtin_amdgcn_sched_barrier(0);
#pragma unroll
                for (int st = 0; st < NS; ++st) {
                    pr[0] = __builtin_amdgcn_mfma_f32_32x32x16_bf16(kf[0][st], qf[st], st == 0 ? negm : pr[0], 0, 0, 0);
                    pr[1] = __builtin_amdgcn_mfma_f32_32x32x16_bf16(kf[1][st], qf[st], st == 0 ? negm : pr[1], 0, 0, 0); }
            }
            const int tp0 = (t == 0) ? -16 : (t - 1) * 64;
            if (DIFF) {
                if (tp0 + 63 - qpos_w > -128) {
#pragma unroll
                    for (int kb = 0; kb < 2; ++kb)
#pragma unroll
                        for (int r = 0; r < 16; ++r) { const int kvi = kb * 32 + 8 * (r >> 2) + 4 * hi + (r & 3); int idx = tp0 + kvi - qpos + 128; idx = idx < 0 ? 0 : idx; pr[kb][r] += lut[idx]; }
                }
            }
            const int nval = (t == 0) ? 16 : (t == NT - 1 ? lastv : 64);
            if (nval < 64) {
#pragma unroll
                for (int kb = 0; kb < 2; ++kb)
#pragma unroll
                    for (int r = 0; r < 16; ++r) { const int kvi = kb * 32 + 8 * (r >> 2) + 4 * hi + (r & 3); if (kvi >= nval) pr[kb][r] = -INFINITY; }
            }
            float mx;
            { float a0 = fmaxf(fmaxf(pr[0][0], pr[0][1]), pr[0][2]), a1 = fmaxf(fmaxf(pr[1][0], pr[1][1]), pr[1][2]);
#pragma unroll
              for (int r = 3; r < 15; r += 2) { a0 = fmaxf(fmaxf(a0, pr[0][r]), pr[0][r + 1]); a1 = fmaxf(fmaxf(a1, pr[1][r]), pr[1][r + 1]); }
              mx = fmaxf(fmaxf(a0, a1), fmaxf(pr[0][15], pr[1][15])); }
            mx = fmaxf(mx, shx(mx, 32, lane));
            if (t == 0 || __any(mx > 8.0f)) {
                const float dl = (t == 0) ? mx : fmaxf(mx, 0.f);
                mrun += dl;
#pragma unroll
                for (int r = 0; r < 16; ++r) negm[r] = -mrun;
                const float alpha = (t == 0) ? 1.f : __builtin_amdgcn_exp2f(-dl); lsum *= alpha;
#pragma unroll
                for (int kb = 0; kb < 2; ++kb) pr[kb] = pr[kb] - dl;
#pragma unroll
                for (int db = 0; db < NDB; ++db) o[db] = o[db] * alpha;
            }
            f32x2 ps2 = (f32x2){0.f, 0.f};
#pragma unroll
            for (int kb = 0; kb < 2; ++kb)
#pragma unroll
                for (int r = 0; r < 16; r += 2) { const float e0 = __builtin_amdgcn_exp2f(pr[kb][r]), e1 = __builtin_amdgcn_exp2f(pr[kb][r + 1]); pr[kb][r] = e0; pr[kb][r + 1] = e1; ps2 += (f32x2){e0, e1}; }
            lsum += ps2[0] + ps2[1];
            __builtin_amdgcn_sched_barrier(0);
            VLOAD(vfb, 1); __builtin_amdgcn_sched_barrier(0); PVMMA(vfa, 0); __builtin_amdgcn_sched_barrier(0);
            VLOAD(vfa, 2); __builtin_amdgcn_sched_barrier(0); PVMMA(vfb, 1); __builtin_amdgcn_sched_barrier(0);
            VLOAD(vfb, 3); __builtin_amdgcn_sched_barrier(0); PVMMA(vfa, 2); __builtin_amdgcn_sched_barrier(0);
            PVMMA(vfb, 3);
#undef VLOAD
#undef PVMMA
        }
        if (t + 1 < NT) ATT_LSTORE(buf ^ 1);
        __syncthreads();
    }
#undef ATT_GLOAD
#undef ATT_LSTORE
    const float ltot = lsum + shx(lsum, 32, lane); const float inv = 1.f / ltot;
    if (DIFF) {
        LAS float* X = (LAS float*)lds;
        if (s == 1) {
#pragma unroll
            for (int db = 0; db < NDB; ++db)
#pragma unroll
                for (int r = 0; r < 16; ++r) X[(db * 16 + r) * 256 + (wid & 3) * 64 + lane] = o[db][r] * inv;
        }
        __syncthreads();
        if (s == 0) {
            float ss = 0.f;
#pragma unroll
            for (int db = 0; db < NDB; ++db)
#pragma unroll
                for (int r = 0; r < 16; ++r) { const float v = o[db][r] * inv - lam * X[(db * 16 + r) * 256 + (wid & 3) * 64 + lane]; o[db][r] = v; ss += v * v; }
            ss += shx(ss, 32, lane);
            const float rstd = oscale / sqrtf(ss * (1.f / 128.f) + EPS);
            if (l32 < nqv) {
                bf16_t* op = Og + (size_t)(qrow_w + l32) * 1024 + hx * 128 + 4 * hi;
#pragma unroll
                for (int db = 0; db < NDB; ++db)
#pragma unroll
                    for (int g4 = 0; g4 < 4; ++g4) { const f32x4 gv = *(const f32x4*)(subg + db * 32 + 8 * g4 + 4 * hi); f32x4 v;
                        v[0] = o[db][4 * g4] * rstd * gv[0]; v[1] = o[db][4 * g4 + 1] * rstd * gv[1]; v[2] = o[db][4 * g4 + 2] * rstd * gv[2]; v[3] = o[db][4 * g4 + 3] * rstd * gv[3];
                        *(u32x2*)(op + db * 32 + 8 * g4) = pk4(v); }
            }
        }
        __syncthreads();
    } else {
        if (l32 < nqv) {
            bf16_t* op = Og + (size_t)(qrow_w + l32) * 512 + (hx * 2 + s) * 64 + 4 * hi;
#pragma unroll
            for (int db = 0; db < NDB; ++db)
#pragma unroll
                for (int g4 = 0; g4 < 4; ++g4) { f32x4 v; v[0] = o[db][4 * g4] * inv; v[1] = o[db][4 * g4 + 1] * inv; v[2] = o[db][4 * g4 + 2] * inv; v[3] = o[db][4 * g4 + 3] * inv;
                    *(u32x2*)(op + db * 32 + 8 * g4) = pk4(v); }
        }
    }
}

template <bool DIFF>
__device__ __forceinline__ void attn_dispatch(LAS unsigned char* lds, KP p, int l, int type, int b, int hx, int j) {
    unsigned char* ws = p->ws;
    const int wid = __builtin_amdgcn_readfirstlane(tid_fresh() >> 6), qg = wid & 3;
    int NT, lastv = 64, kbase, qrow_w = 0, qpos_w = 0, nqv = 0, nt_w = 0;
    if (type == 0) { NT = 2 * j + 3; const int chunk = 2 * j + (qg >> 1); qpos_w = chunk * 64 + (qg & 1) * 32; qrow_w = b * 4096 + qpos_w; nt_w = 2 * j + 2 + (qg >> 1); nqv = 32; kbase = b * KPR; }
    else if (type == 1) { NT = 18; lastv = 16; kbase = KS0 + b * KSR; if (qg == 0) { qrow_w = RS0 + b * 16; qpos_w = 1024; nqv = 16; nt_w = 18; } }
    else { NT = 1; kbase = 0; if (qg == 0) { qrow_w = RM0; qpos_w = -16; nqv = 16; nt_w = 1; } }
    if (DIFF) {
        const float li = 0.8f - 0.6f * expf(-0.3f * (float)l);
        attn_unit<true>(lds, (const bf16_t*)(ws + W_QA), (const bf16_t*)(ws + W_KA), (const bf16_t*)(ws + W_VA), (bf16_t*)(ws + W_OA), kbase, hx, NT, lastv, qrow_w, qpos_w, nqv, nt_w,
                        (const float*)(ws + W_LUT), ((const float*)(ws + W_LAM))[l], 1.f - li, p->in[12] + l * 128);
    } else {
        attn_unit<false>(lds, (const bf16_t*)(ws + W_QM), (const bf16_t*)(ws + W_KM), (const bf16_t*)(ws + W_VM), (bf16_t*)(ws + W_OB), kbase, hx, NT, lastv, qrow_w, qpos_w, nqv, nt_w,
                         nullptr, 0.f, 1.f, nullptr);
    }
}
template <bool DIFF>
__device__ __forceinline__ void attn_phase(LAS unsigned char* lds, KP p, int l) {
    constexpr int NH = DIFF ? 8 : 4, NPAIR = 8 * NH * 16, NSMP = 8 * NH, NMT = NH;
    int cu = blockIdx.x, G = gridDim.x; asm volatile("" : "+s"(cu), "+s"(G));
    const int vcu = (G & 7) == 0 ? (cu & 7) * (G >> 3) + (cu >> 3) : cu;
    for (int it = vcu; it < NPAIR + NSMP + NMT; it += G) {
        if (it < NPAIR) { const int b = it / (NH * 16), hx = (it >> 4) % NH, j = it & 15;
            attn_dispatch<DIFF>(lds, p, l, 0, b, hx, j); attn_dispatch<DIFF>(lds, p, l, 0, b, hx, 31 - j); }
        else if (it < NPAIR + NSMP) { const int i = it - NPAIR; attn_dispatch<DIFF>(lds, p, l, 1, i / NH, i % NH, 0); }
        else attn_dispatch<DIFF>(lds, p, l, 2, 0, it - NPAIR - NSMP, 0);
    }
}

constexpr int LDS_BYTES = 135168;
template <class Epi> __device__ __forceinline__ void run_gemm(LAS unsigned char* lds, const bf16_t* A, const bf16_t* Bt, int M, int N, int K, int c, const Epi& E, int tail_pm = -1, int nsplit = 0) {
    asm volatile("" : "+s"(K));
    pg8::Gemm g{A, Bt, M, N, K}; int G = (int)gridDim.x; asm volatile("" : "+s"(G)); pg8::StaticOrder S; S.init(M, N, G, c, K, tail_pm, nsplit);
    pg8::gemm_phase<Epi, pg8::StaticOrder, true, true>(lds, g, S, E);
}

__global__ void __launch_bounds__(512, 2) fwd_megakernel(Params p_arg) {
    cg::grid_group grid = cg::this_grid();
    extern __shared__ __attribute__((aligned(16))) unsigned char lds_[];
    LAS unsigned char* lds = (LAS unsigned char*)lds_;
    KP kp0 = (KP)__builtin_amdgcn_kernarg_segment_ptr();
#define FRESH() KP p = kp0; asm volatile("" : "+s"(p)); unsigned char* ws = p->ws; (void)ws; const int tid = tid_fresh(), lane = tid & 63, wave = __builtin_amdgcn_readfirstlane(tid >> 6); int cu = blockIdx.x; asm volatile("" : "+s"(cu)); const int gw = cu * 8 + wave; (void)lane; (void)gw
    const int NGW = gridDim.x * 8;
    volatile LAS unsigned* MISC = (volatile LAS unsigned*)(lds + 132096);
    if (threadIdx.x < 16) MISC[threadIdx.x] = 0u;
    __syncthreads();
    const XcdBarrier bar = xcd_barrier_post((unsigned*)(kp0->ws + W_BAR), MISC);
#define GSYNC() xcd_barrier(bar)

    { FRESH(); phase_prologue(p, lds, gw, NGW, wave, lane); }
    grid.sync();
#pragma unroll 1
    for (int l = 0; l < 4; ++l) {
#define WTL ((const bf16_t*)(ws + W_WT) + (size_t)l * WL)
        { FRESH(); phase_norm(p, l, p->in[9] + l * 1024, gw, NGW, lane, l == 0, l == 0 ? 0 : 11); phase_cache_conv(p, l, gw, NGW, lane); }
        GSYNC();
        { FRESH(); EpiIn E{(bf16_t*)(ws + W_QA), (bf16_t*)(ws + W_KA), (bf16_t*)(ws + W_VA), (bf16_t*)(ws + W_GA), (bf16_t*)(ws + W_GB), (float*)(ws + W_ZR),
                  p->out + O_AKP + (size_t)l * 8 * 4112 * 1024, p->out + O_AKS + (size_t)l * 128 * 1024, p->out + O_AVP + (size_t)l * 8 * 4112 * 1024, p->out + O_AVS + (size_t)l * 128 * 1024, (bf16_t*)(ws + W_CQN)};
          run_gemm(lds, (const bf16_t*)(ws + W_XN), WTL + WO_IN, R, NINP, 1024, cu, E); }
        GSYNC();
        { FRESH(); phase_mlaprep(p, l, gw, NGW, lane); }
        __syncthreads();
        { FRESH(); attn_phase<true>(lds, p, l); }
        GSYNC();
        { FRESH(); EpiUq E{(bf16_t*)(ws + W_QM), (const float*)(ws + W_RT)}; run_gemm(lds, (const bf16_t*)(ws + W_CQN), WTL + WO_UQ, R, 768, 768, cu, E); }
        { FRESH(); EpiKv E{(bf16_t*)(ws + W_KM), (bf16_t*)(ws + W_VM)}; run_gemm(lds, (const bf16_t*)(ws + W_CKVA), WTL + WO_UKV, RX, 1024, 256, (cu + 128) & 255, E); }
        GSYNC();
        { FRESH(); attn_phase<false>(lds, p, l); }
        GSYNC();
        { FRESH(); EpiBrA E{(const bf16_t*)(ws + W_GA), (bf16_t*)(ws + W_T1)}; run_gemm(lds, (const bf16_t*)(ws + W_OA), WTL + WO_A, R, 1024, 1024, cu, E); }
        { FRESH(); EpiBrB E{(const bf16_t*)(ws + W_GB), (const bf16_t*)(ws + W_T1), (bf16_t*)(ws + W_MM)}; run_gemm(lds, (const bf16_t*)(ws + W_OB), WTL + WO_B, R, 1024, 512, cu, E); }
        GSYNC();
        { FRESH(); EpiRes E{(bf16_t*)(ws + W_H), 16, (float*)(ws + W_PART)}; run_gemm(lds, (const bf16_t*)(ws + W_MM), WTL + WO_O, RP, 1024, 1024, cu, E, 128, 8); }
        GSYNC();
        { FRESH(); phase_norm(p, l, p->in[20] + l * 1024, gw, NGW, lane, false, 8); }
        GSYNC();
        { FRESH(); EpiUp E{(bf16_t*)(ws + W_U), p->out + O_CVP + (size_t)l * 16 * DFF2, p->out + O_CVS + (size_t)l * 16 * DFF2}; run_gemm(lds, (const bf16_t*)(ws + W_XN), WTL + WO_UP, R, DFF2, 1024, cu, E); }
        GSYNC();
        { FRESH(); phase_conv(p, l, gw, NGW, lane); }
        GSYNC();
        { FRESH(); EpiRes E{(bf16_t*)(ws + W_H), DFF / 64, (float*)(ws + W_PART)}; run_gemm(lds, (const bf16_t*)(ws + W_ACT), WTL + WO_D, RP, 1024, DFF, cu, E, 128, 11); }
        GSYNC();
    }
    { FRESH(); phase_final(p, gw, NGW, lane); }
#undef WTL
#undef FRESH
#undef GSYNC
}
}

extern "C" void kernel_launch(void* const* d_in, const int* in_sizes, int n_in, void* d_out, int out_size, void* d_ws, size_t ws_size, hipStream_t stream) {
    static int grid = 0;
    if (!grid) {
        int dev = 0, cus = 0, per = 0;
        if (n_in != 26 || (size_t)out_size != mk::O_END || ws_size < mk::W_END) { fprintf(stderr, "kernel_launch: unexpected shapes (n_in %d out %d ws %zu need %zu)\n", n_in, out_size, ws_size, (size_t)mk::W_END); grid = -1; return; }
        (void)hipGetDevice(&dev); (void)hipDeviceGetAttribute(&cus, hipDeviceAttributeMultiprocessorCount, dev);
        (void)hipFuncSetAttribute((const void*)mk::fwd_megakernel, hipFuncAttributeMaxDynamicSharedMemorySize, mk::LDS_BYTES);
        (void)hipOccupancyMaxActiveBlocksPerMultiprocessor(&per, mk::fwd_megakernel, 512, mk::LDS_BYTES);
        if (per < 1) per = 1;
        grid = cus * per;
    }
    if (grid <= 0) return;
    mk::Params p{};
    for (int i = 0; i < 26; ++i) p.in[i] = (const float*)d_in[i];
    p.out = (float*)d_out; p.ws = (unsigned char*)d_ws;
    if (hipMemsetAsync((char*)d_ws + mk::W_BAR, 0, 16384, stream) != hipSuccess) { fprintf(stderr, "kernel_launch: memset of the barrier words failed\n"); return; }
    void* args[] = {&p};
    hipError_t e = hipLaunchCooperativeKernel((void*)mk::fwd_megakernel, dim3(grid), dim3(512), args, mk::LDS_BYTES, stream);
    if (e != hipSuccess) fprintf(stderr, "cooperative launch failed: %s (grid %d)\n", hipGetErrorString(e), grid);
}
```

```cpp
#include <hip/hip_runtime.h>
#include <hip/hip_cooperative_groups.h>
#include <cstdio>
#include <cstdint>
namespace cg = cooperative_groups;
namespace pg8 {
#define PG8_LAS __attribute__((address_space(3)))
typedef unsigned short bf16_t;
typedef short bf16x8 __attribute__((ext_vector_type(8)));
typedef float f32x4 __attribute__((ext_vector_type(4)));
typedef unsigned u32x4 __attribute__((ext_vector_type(4)));
constexpr int BM = 256, BK = 64, HALF = 128, HTB = HALF * BK * 2  , STAGE_BYTES = 8 * HTB, NXCD = 8, WGM = 8;

__host__ __device__ __forceinline__ int lds_byte(int r, int c) { const int st = (r >> 4) * 2 + (c >> 5), rr = r & 15, cc = c & 31, ob = rr * 64 + cc * 2; return st * 1024 + (ob ^ (((ob >> 9) & 1) << 5)); }
__host__ __device__ __forceinline__ void stage_rc(int b, int& R, int& C) { const int st = b / 1024, sb = b % 1024, swz = sb ^ (((sb >> 9) & 1) << 5); R = (st >> 1) * 16 + swz / 64; C = (st & 1) * 32 + (swz % 64) / 2; }
__host__ __device__ __forceinline__ int perm32(int rho) { const int n = rho >> 4, i = rho & 15; return 8 * (i >> 2) + 4 * n + (i & 3); }

struct Unit { int pm, pn, k0, nt; };
struct Gemm { const bf16_t* A; const bf16_t* Bt; int M, N, K; };

struct StaticOrder {
    int nM, nN, nwg, G, c, ntf, tail_pm, nsplit, ksub;
    __host__ __device__ void init(int M, int N, int G_, int c_, int K_ = 0, int tail_pm_ = -1, int nsplit_ = 0) { nM = M / BM; nN = N / BM; nwg = nM * nN; G = G_; c = c_; ntf = K_ / BK; tail_pm = tail_pm_; nsplit = nsplit_; ksub = nsplit_ ? K_ / nsplit_ : 0; }
    __host__ __device__ bool next(int i, Unit& u) const {
        const long L = (long)i * G + c;
        if (L >= nwg) { const int idx = (int)(L - nwg); if (idx >= nN * nsplit) return false;
            u.pm = tail_pm; u.pn = idx % nN; u.k0 = (idx / nN) * ksub; u.nt = ksub / BK; return true; }
        int wgid = (int)L; { const int q = nwg / NXCD, r = nwg % NXCD, xcd = wgid % NXCD, off = wgid / NXCD; wgid = (xcd < r ? xcd * (q + 1) : r * (q + 1) + (xcd - r) * q) + off; }
        const int nig = WGM * nN, gid = wgid / nig, fm = gid * WGM, gsz = (nM - fm) < WGM ? (nM - fm) : WGM;
        u.pm = fm + ((wgid % nig) % gsz); u.pn = (wgid % nig) / gsz; u.k0 = 0; u.nt = ntf; return true;
    }
    __device__ __forceinline__ void a_ready(const Unit&) const {}
    __device__ __forceinline__ void done(const Unit&) const {}
};

__device__ __forceinline__ unsigned cvt_pk_bf16(float lo, float hi) { unsigned r; asm volatile("v_cvt_pk_bf16_f32 %0, %1, %2" : "=v"(r) : "v"(lo), "v"(hi)); return r; }
typedef float f32x2 __attribute__((ext_vector_type(2)));
template <class Epi, class Sched, bool ALIGN_EPI = false, bool SP2 = false>
__device__ __forceinline__ void gemm_phase(PG8_LAS unsigned char* lds, const Gemm g, const Sched& S, const Epi& E) {
    int tid_ = threadIdx.x; asm volatile("" : "+v"(tid_));
    const int tid = tid_, wid = __builtin_amdgcn_readfirstlane(tid >> 6), lane = tid & 63, wr = wid >> 2, wc = wid & 3, fr = lane & 15, fq = lane >> 4;
    const int K = g.K;
    unsigned voffA[2], voffB[2];
#pragma unroll
    for (int i = 0; i < 2; ++i) { int R, C; stage_rc(tid * 16 + i * 8192, R, C); const int Rb = Epi::PERM ? ((R & ~31) + perm32(R & 31)) : R;
        voffA[i] = (unsigned)(R * K + C) * 2u; voffB[i] = (unsigned)(Rb * K + C) * 2u; }
    const size_t kstep = (size_t)(BK * 2);
    const size_t hstep = (size_t)HALF * K * 2;
    const size_t tstep = 2 * hstep;
    const unsigned ldsw = (unsigned)wid * 1024u;
    const int aoff = lds_byte(wr * 64 + fr, fq * 8), boff = lds_byte(wc * 32 + fr, fq * 8);
#define PG8_SA(b, h) (((b) * 2 + (h)) * HTB)
#define PG8_SB(b, h) ((4 + (b) * 2 + (h)) * HTB)
#define PG8_STAGE(bufoff, gbase, voff) do { _Pragma("unroll") for (int _i = 0; _i < 2; ++_i) \
        __builtin_amdgcn_global_load_lds((const unsigned*)((const char*)(gbase) + (voff)[_i]), (PG8_LAS unsigned*)(lds + (bufoff) + ldsw + _i * 8192), 16, 0, 0); } while (0)
#define PG8_LDA(dst, b, h) do { _Pragma("unroll") for (int m = 0; m < 4; ++m) _Pragma("unroll") for (int k = 0; k < 2; ++k) dst[m][k] = *(const PG8_LAS bf16x8*)(lds + PG8_SA(b, h) + aoff + m * 2048 + k * 1024); } while (0)
#define PG8_LDB(dst, b, h) do { _Pragma("unroll") for (int n = 0; n < 2; ++n) _Pragma("unroll") for (int k = 0; k < 2; ++k) dst[n][k] = *(const PG8_LAS bf16x8*)(lds + PG8_SB(b, h) + boff + n * 2048 + k * 1024); } while (0)
#define PG8_MMA(ai, bj, At, Bt) do { __builtin_amdgcn_s_setprio(1); _Pragma("unroll") for (int m = 0; m < 4; ++m) _Pragma("unroll") for (int n = 0; n < 2; ++n) _Pragma("unroll") for (int k = 0; k < 2; ++k) \
        acc[ai][bj][m][n] = __builtin_amdgcn_mfma_f32_16x16x32_bf16(Bt[n][k], At[m][k], acc[ai][bj][m][n], 0, 0, 0); __builtin_amdgcn_s_setprio(0); } while (0)
#define PG8_WAIT_V(n) asm volatile("s_waitcnt vmcnt(" #n ")" ::: "memory")
#define PG8_WAIT_L(n) asm volatile("s_waitcnt lgkmcnt(" #n ")" ::: "memory")
#define PG8_BAR __builtin_amdgcn_s_barrier()
#define PG8_SCHED __builtin_amdgcn_sched_barrier(0)
    Unit cur, nxt; int ui = 0;
    if (!S.next(0, cur)) return;
    f32x4 acc[2][2][4][2];
#pragma unroll
    for (int a = 0; a < 2; ++a)
#pragma unroll
        for (int b = 0; b < 2; ++b)
#pragma unroll
            for (int m = 0; m < 4; ++m)
#pragma unroll
                for (int n = 0; n < 2; ++n) acc[a][b][m][n] = (f32x4){0.f, 0.f, 0.f, 0.f};
    bf16x8 At[4][2], B0[2][2], B1[2][2];
    const char* cA = (const char*)g.A + (size_t)cur.pm * tstep + (size_t)cur.k0 * 2; const char* cB = (const char*)g.Bt + (size_t)cur.pn * tstep + (size_t)cur.k0 * 2;
    S.a_ready(cur);
    if constexpr (SP2) {
        PG8_STAGE(PG8_SB(0, 0), cB, voffB); PG8_STAGE(PG8_SB(0, 1), cB + hstep, voffB); PG8_STAGE(PG8_SA(0, 0), cA, voffA); PG8_STAGE(PG8_SA(0, 1), cA + hstep, voffA);
        if (wr == 1) PG8_BAR;
        PG8_WAIT_V(2); PG8_BAR;
        PG8_STAGE(PG8_SB(1, 0), cB + kstep, voffB); PG8_STAGE(PG8_SA(1, 0), cA + kstep, voffA); PG8_STAGE(PG8_SB(1, 1), cB + hstep + kstep, voffB);
        PG8_WAIT_V(6); PG8_BAR;
    } else {
        PG8_STAGE(PG8_SB(0, 0), cB, voffB); PG8_STAGE(PG8_SA(0, 0), cA, voffA); PG8_STAGE(PG8_SB(0, 1), cB + hstep, voffB); PG8_STAGE(PG8_SA(0, 1), cA + hstep, voffA);
        if (wr == 1) PG8_BAR;
        PG8_WAIT_V(4); PG8_BAR;
        PG8_STAGE(PG8_SB(1, 0), cB + kstep, voffB); PG8_STAGE(PG8_SA(1, 0), cA + kstep, voffA); PG8_STAGE(PG8_SB(1, 1), cB + hstep + kstep, voffB);
        PG8_WAIT_V(6); PG8_BAR;
    }
    for (;;) {
        const bool has_next = S.next(ui + 1, nxt);
        const char* nA = has_next ? (const char*)g.A + (size_t)nxt.pm * tstep + (size_t)nxt.k0 * 2 : cA; const char* nB = has_next ? (const char*)g.Bt + (size_t)nxt.pn * tstep + (size_t)nxt.k0 * 2 : cB;
        const int ntc = cur.nt;
        for (int t = 0; t < ntc; t += 2) {
            const bool last = (t == ntc - 2);
            const char* a1 = cA + (size_t)(t + 1) * kstep;
            const char* a2 = last ? nA : cA + (size_t)(t + 2) * kstep; const char* b2 = last ? nB : cB + (size_t)(t + 2) * kstep;
            const char* a3 = a2 + kstep; const char* b3 = b2 + kstep;
            if (last && has_next) S.a_ready(nxt);
            if constexpr (SP2) {
            PG8_LDB(B0, 0, 0); PG8_LDB(B1, 0, 1); PG8_SCHED; PG8_LDA(At, 0, 0); PG8_STAGE(PG8_SA(1, 1), a1 + hstep, voffA);
            PG8_WAIT_V(8); PG8_WAIT_L(0); PG8_BAR; PG8_MMA(0, 0, At, B0); PG8_MMA(0, 1, At, B1); PG8_BAR; PG8_SCHED;
            PG8_LDA(At, 0, 1); PG8_STAGE(PG8_SB(0, 0), b2, voffB); PG8_STAGE(PG8_SB(0, 1), b2 + hstep, voffB); PG8_STAGE(PG8_SA(0, 0), a2, voffA);
            PG8_WAIT_V(8); PG8_WAIT_L(0); PG8_BAR; PG8_MMA(1, 0, At, B0); PG8_MMA(1, 1, At, B1); PG8_BAR; PG8_SCHED;
            PG8_LDB(B0, 1, 0); PG8_LDB(B1, 1, 1); PG8_SCHED; PG8_LDA(At, 1, 0); PG8_STAGE(PG8_SA(0, 1), a2 + hstep, voffA);
            PG8_WAIT_V(8); PG8_WAIT_L(0); PG8_BAR; PG8_MMA(0, 0, At, B0); PG8_MMA(0, 1, At, B1); PG8_BAR; PG8_SCHED;
            PG8_LDA(At, 1, 1); PG8_STAGE(PG8_SB(1, 0), b3, voffB); PG8_STAGE(PG8_SB(1, 1), b3 + hstep, voffB); PG8_STAGE(PG8_SA(1, 0), a3, voffA);
            PG8_WAIT_V(8); PG8_WAIT_L(0); PG8_BAR; PG8_MMA(1, 0, At, B0); PG8_MMA(1, 1, At, B1); PG8_BAR; PG8_SCHED;
            } else {
            PG8_LDB(B0, 0, 0); PG8_SCHED; PG8_LDA(At, 0, 0); PG8_STAGE(PG8_SA(1, 1), a1 + hstep, voffA);
            PG8_WAIT_L(8); PG8_BAR; PG8_WAIT_L(0); PG8_MMA(0, 0, At, B0); PG8_BAR; PG8_SCHED;
            PG8_LDB(B1, 0, 1); PG8_STAGE(PG8_SB(0, 0), b2, voffB);
            PG8_BAR; PG8_WAIT_L(0); PG8_MMA(0, 1, At, B1); PG8_BAR;
            PG8_LDA(At, 0, 1); PG8_STAGE(PG8_SA(0, 0), a2, voffA);
            PG8_BAR; PG8_WAIT_L(0); PG8_MMA(1, 0, At, B0); PG8_BAR; PG8_SCHED;
            PG8_STAGE(PG8_SB(0, 1), b2 + hstep, voffB);
            PG8_WAIT_V(6); PG8_BAR; PG8_MMA(1, 1, At, B1); PG8_BAR;
            PG8_LDB(B0, 1, 0); PG8_SCHED; PG8_LDA(At, 1, 0); PG8_STAGE(PG8_SA(0, 1), a2 + hstep, voffA);
            PG8_WAIT_L(8); PG8_BAR; PG8_WAIT_L(0); PG8_MMA(0, 0, At, B0); PG8_BAR; PG8_SCHED;
            PG8_LDB(B1, 1, 1); PG8_STAGE(PG8_SB(1, 0), b3, voffB);
            PG8_BAR; PG8_WAIT_L(0); PG8_MMA(0, 1, At, B1); PG8_BAR;
            PG8_LDA(At, 1, 1); PG8_STAGE(PG8_SA(1, 0), a3, voffA);
            PG8_BAR; PG8_WAIT_L(0); PG8_MMA(1, 0, At, B0); PG8_BAR; PG8_SCHED;
            PG8_STAGE(PG8_SB(1, 1), b3 + hstep, voffB);
            PG8_WAIT_V(6); PG8_BAR; PG8_MMA(1, 1, At, B1); PG8_BAR;
            }
        }
        if constexpr (ALIGN_EPI) { if (wr == 0) PG8_BAR; }
        if constexpr (!Epi::AFTER_DRAIN) { E(acc, cur, wr, wc, fr, fq); S.done(cur); }
        if (!has_next) break;
#pragma unroll
        for (int a = 0; a < 2; ++a)
#pragma unroll
            for (int b = 0; b < 2; ++b)
#pragma unroll
                for (int m = 0; m < 4; ++m)
#pragma unroll
                    for (int n = 0; n < 2; ++n) acc[a][b][m][n] = (f32x4){0.f, 0.f, 0.f, 0.f};
        cur = nxt; cA = nA; cB = nB; ++ui;
        if constexpr (ALIGN_EPI) { if (wr == 1) PG8_BAR; }
    }
    PG8_WAIT_V(0);
    if constexpr (!ALIGN_EPI) { if (wr == 0) PG8_BAR; }
    PG8_BAR;
    if constexpr (Epi::AFTER_DRAIN) { E.fused(acc, cur, wr, wc, fr, fq, lds, wid, lane); S.done(cur); }
#undef PG8_SA
#undef PG8_SB
#undef PG8_STAGE
#undef PG8_LDA
#undef PG8_LDB
#undef PG8_MMA
#undef PG8_WAIT_V
#undef PG8_WAIT_L
#undef PG8_BAR
#undef PG8_SCHED
}
}
namespace mk {
using pg8::bf16_t; using pg8::f32x4; using pg8::u32x4; using pg8::bf16x8; using pg8::Unit;
#define LAS __attribute__((address_space(3)))
typedef float f32x16 __attribute__((ext_vector_type(16)));
typedef unsigned u32x2 __attribute__((ext_vector_type(2)));
typedef float f32x2 __attribute__((ext_vector_type(2)));
typedef short v4i16_t __attribute__((ext_vector_type(4)));

constexpr int DM = 1024, SEQ = 4096;
constexpr int RP = 32768;
constexpr int RS0 = RP, RS1 = RP + 128;
constexpr int RM0 = RS1, RM1 = RM0 + 16;
constexpr int R = 33024;
constexpr int RC = 8192, RX = R + RC;
constexpr int KPR = 64 + SEQ;
constexpr int KSR = 64 + 1024 + 64;
constexpr int KS0 = 8 * KPR;
constexpr int MT = KS0 + 8 * KSR;
constexpr int TK = MT + 64;
constexpr int NIN = 6176, NINP = 6400, DFF = 2816, DFF2 = 5632, ZRW = 1056;
constexpr float EPS = 1e-6f;
constexpr float QS_A = 0.18033688011112042f, QS_B = 0.14724444602590306f, LOG2E = 1.4426950408889634f;

constexpr size_t O_YP = 0, O_YS = O_YP + (size_t)RP * DM, O_AKP = O_YS + (size_t)128 * DM, O_AKS = O_AKP + (size_t)4 * 8 * 4112 * 1024,
    O_AVP = O_AKS + (size_t)4 * 8 * 16 * 1024, O_AVS = O_AVP + (size_t)4 * 8 * 4112 * 1024, O_CKP = O_AVS + (size_t)4 * 8 * 16 * 1024,
    O_CKS = O_CKP + (size_t)4 * 8 * 4112 * 256, O_KRP = O_CKS + (size_t)4 * 8 * 16 * 256, O_KRS = O_KRP + (size_t)4 * 8 * 4112 * 32,
    O_CVP = O_KRS + (size_t)4 * 8 * 16 * 32, O_CVS = O_CVP + (size_t)4 * 8 * 2 * 5632, O_END = O_CVS + (size_t)4 * 8 * 2 * 5632;
static_assert(O_END == 342982656, "output size");

constexpr size_t WO_IN = 0, WO_UQ = WO_IN + (size_t)NINP * 1024, WO_UKV = WO_UQ + (size_t)768 * 768, WO_A = WO_UKV + (size_t)1024 * 256,
    WO_B = WO_A + (size_t)1024 * 1024, WO_O = WO_B + (size_t)1024 * 512, WO_UP = WO_O + (size_t)1024 * 1024, WO_D = WO_UP + (size_t)DFF2 * 1024,
    WL = WO_D + (size_t)1024 * DFF;

constexpr size_t al256(size_t x) { return (x + 255) & ~(size_t)255; }
constexpr size_t W_H = 0;
constexpr size_t W_XN = al256(W_H + (size_t)R * 1024 * 4);
constexpr size_t W_WT = al256(W_XN + (size_t)R * 1024 * 2);
constexpr size_t W_QA = al256(W_WT + WL * 4 * 2);
constexpr size_t W_KA = al256(W_QA + (size_t)R * 1024 * 2);
constexpr size_t W_VA = al256(W_KA + (size_t)TK * 1024 * 2);
constexpr size_t W_GA = al256(W_VA + (size_t)TK * 1024 * 2);
constexpr size_t W_GB = al256(W_GA + (size_t)R * 1024 * 2);
constexpr size_t W_ZR = al256(W_GB + (size_t)R * 1024 * 2);
constexpr size_t W_CQN = al256(W_ZR + (size_t)R * ZRW * 4);
constexpr size_t W_CKVA = al256(W_CQN + (size_t)R * 768 * 2);
constexpr size_t W_QM = al256(W_CKVA + (size_t)RX * 256 * 2);
constexpr size_t W_KM = al256(W_QM + (size_t)R * 768 * 2);
constexpr size_t W_VM = al256(W_KM + (size_t)TK * 768 * 2);
constexpr size_t W_OA = al256(W_VM + (size_t)TK * 512 * 2);
constexpr size_t W_OB = al256(W_OA + (size_t)R * 1024 * 2);
constexpr size_t W_T1 = al256(W_OB + (size_t)R * 512 * 2);
constexpr size_t W_MM = al256(W_T1 + (size_t)R * 1024 * 4);
constexpr size_t W_U = al256(W_MM + (size_t)R * 1024 * 2);
constexpr size_t W_ACT = al256(W_U + (size_t)R * DFF2 * 2);
constexpr size_t W_LUT = al256(W_ACT + (size_t)R * DFF * 2);
constexpr size_t W_LAM = al256(W_LUT + 8 * 192 * 4);
constexpr size_t W_RT = al256(W_LAM + 64);
constexpr size_t W_PART = al256(W_RT + (size_t)4128 * 16 * 8);
constexpr size_t W_BAR = al256(W_PART + (size_t)11 * 256 * 1024 * 4);
constexpr size_t W_END = al256(W_BAR + 16384);

struct Params { const float* in[26]; float* out; unsigned char* ws; };
typedef const Params __attribute__((address_space(4)))* KP;

__device__ const float ROPE_INV[16] = {1.f, 0.562341332f, 0.316227764f, 0.177827939f, 0.100000001f, 0.0562341325f, 0.0316227749f, 0.0177827943f,
    0.00999999978f, 0.00562341325f, 0.00316227763f, 0.00177827943f, 0.00100000005f, 0.000562341302f, 0.000316227757f, 0.00017782794f};

__device__ __forceinline__ int tid_fresh() { int t = threadIdx.x; asm volatile("" : "+v"(t)); return t; }
__device__ __forceinline__ float shx(float v, int mask, int lane) { return __int_as_float(__builtin_amdgcn_ds_bpermute((lane ^ mask) << 2, __float_as_int(v))); }
__device__ __forceinline__ float wave_sum(float v, int lane) {
#pragma unroll
    for (int o = 1; o < 64; o <<= 1) v += shx(v, o, lane);
    return v;
}
__device__ __forceinline__ unsigned pk2(float lo, float hi) { return pg8::cvt_pk_bf16(lo, hi); }
__device__ __forceinline__ u32x2 pk4(f32x4 v) { u32x2 w; w.x = pk2(v[0], v[1]); w.y = pk2(v[2], v[3]); return w; }
__device__ __forceinline__ float bf2f(unsigned short b) { return __uint_as_float((unsigned)b << 16); }
__device__ __forceinline__ float sigmoidf_(float z) { return 1.f / (1.f + __expf(-z)); }
__device__ __forceinline__ f32x4 ldbf4(const bf16_t* p) { const u32x2 w = *(const u32x2*)p; f32x4 v; v[0] = __uint_as_float(w.x << 16); v[1] = __uint_as_float(w.x & 0xffff0000u); v[2] = __uint_as_float(w.y << 16); v[3] = __uint_as_float(w.y & 0xffff0000u); return v; }
#define LDS_WAIT() asm volatile("s_waitcnt lgkmcnt(0)" ::: "memory")

#define XB_TMO      128
#define XB_XCNT(j)  (256  + 64 * (j))
#define XB_XSUB(j)  (1280 + 64 * (j))
#define XB_XGEN(j)  (2304 + 64 * (j))
#define XB_TOP      3328
#define XB_TOPGEN   3392
#define XCD_BAR_WORDS 3456
#define XB_SPIN_CAP (1u << 18)

__device__ __forceinline__ unsigned xb_ld(unsigned* p)              { return __hip_atomic_load(p, __ATOMIC_RELAXED, __HIP_MEMORY_SCOPE_AGENT); }
__device__ __forceinline__ unsigned xb_add(unsigned* p, unsigned v) { return __hip_atomic_fetch_add(p, v, __ATOMIC_RELAXED, __HIP_MEMORY_SCOPE_AGENT); }
__device__ __forceinline__ unsigned xb_xcc_id() { return (unsigned)__builtin_amdgcn_s_getreg((3 << 11) | 20) & 0xFu; }
#define XB_SPIN(cond, bar) do { unsigned _sp = 0; while (cond) { __builtin_amdgcn_s_sleep(1); \
    if ((++_sp & 255u) == 0u) { if (xb_ld(&(bar)[XB_TMO])) break; if (_sp > XB_SPIN_CAP) { atomicAdd(&(bar)[XB_TMO], 1u); break; } } } } while (0)

struct XcdBarrier {
    unsigned* bar; unsigned x;
    volatile LAS unsigned* st;
};

__device__ __forceinline__ XcdBarrier xcd_barrier_post(unsigned* bar, volatile LAS unsigned* st) {
    XcdBarrier b; b.bar = bar; b.x = xb_xcc_id(); b.st = st;
    if (threadIdx.x == 0) (void)xb_add(&bar[XB_XCNT(b.x)], 1u);
    return b;
}
__device__ __forceinline__ void xcd_barrier_complete(unsigned* bar, unsigned x, unsigned& nloc, unsigned& nx) {
    const unsigned G = gridDim.x * gridDim.y * gridDim.z;
    unsigned sum, cnt, mine, sp = 0u;
    for (;;) {
        sum = 0u; cnt = 0u; mine = 0u;
#pragma unroll
        for (unsigned j = 0; j < 16; ++j) { const unsigned c = xb_ld(&bar[XB_XCNT(j)]); sum += c; cnt += (c > 0u) ? 1u : 0u; mine = (j == x) ? c : mine; }
        if (sum == G) break;
        __builtin_amdgcn_s_sleep(1);
        if ((++sp & 255u) == 0u) { if (xb_ld(&bar[XB_TMO])) break; if (sp > XB_SPIN_CAP) { atomicAdd(&bar[XB_TMO], 1u); break; } }
    }
    nloc = mine > 0u ? mine : 1u; nx = cnt > 0u ? cnt : 1u;
}

__device__ __forceinline__ void xcd_barrier(const XcdBarrier& b) {
    asm volatile("s_waitcnt vmcnt(0)" ::: "memory");
    __syncthreads();
    if (threadIdx.x == 0) {
        unsigned* bar = b.bar;
        __builtin_amdgcn_s_waitcnt(0);
        unsigned nloc = b.st[0], nx = b.st[1];
        if (nloc == 0u) { xcd_barrier_complete(bar, b.x, nloc, nx); b.st[0] = nloc; b.st[1] = nx; }
        const unsigned old = xb_add(&bar[XB_XSUB(b.x)], 1u);
        const unsigned gen = old / nloc;
        if (old + 1u == (gen + 1u) * nloc) {
            __builtin_amdgcn_fence(__ATOMIC_RELEASE, "agent");
            asm volatile("s_waitcnt vmcnt(0)" ::: "memory");
            const unsigned og = xb_add(&bar[XB_TOP], 1u);
            const unsigned tg = og / nx;
            if (og + 1u == (tg + 1u) * nx) xb_add(&bar[XB_TOPGEN], 1u);
            else XB_SPIN(xb_ld(&bar[XB_TOPGEN]) == tg, bar);
            __builtin_amdgcn_fence(__ATOMIC_ACQUIRE, "agent");
            xb_add(&bar[XB_XGEN(b.x)], 1u);
            asm volatile("s_waitcnt vmcnt(0)" ::: "memory");
        } else {
            XB_SPIN(xb_ld(&bar[XB_XGEN(b.x)]) == gen, bar);
            __builtin_amdgcn_fence(__ATOMIC_ACQUIRE, "agent");
            asm volatile("s_waitcnt vmcnt(0)" ::: "memory");
        }
    }
    __syncthreads();
}


struct EpiIn {
    static constexpr bool PERM = false, AFTER_DRAIN = false;
    bf16_t *QA, *KA, *VA, *GA, *GB; float* ZR; float *akp, *aks, *avp, *avs;
    bf16_t* CQ;
    __device__ __forceinline__ void operator()(const f32x4 (&acc)[2][2][4][2], const Unit& u, int wr, int wc, int fr, int fq) const {
        const int pn = u.pn, pm = u.pm, lr0 = wr * 64 + fr, lc0 = wc * 32 + 4 * fq;
        if (pn < 4) {
#pragma unroll
            for (int ai = 0; ai < 2; ++ai)
#pragma unroll
                for (int m = 0; m < 4; ++m) { bf16_t* rp = QA + (size_t)(pm * 256 + ai * 128 + m * 16 + lr0) * 1024 + pn * 256 + lc0;
#pragma unroll
                    for (int bj = 0; bj < 2; ++bj)
#pragma unroll
                        for (int n = 0; n < 2; ++n) *(u32x2*)(rp + bj * 128 + n * 16) = pk4(acc[ai][bj][m][n] * QS_A); }
        } else if (pn < 12) {
            const bool isv = pn >= 8; bf16_t* KV = isv ? VA : KA; float* op = isv ? avp : akp; float* os = isv ? avs : aks;
            const int c0 = (pn - (isv ? 8 : 4)) * 256 + lc0;
            if (pm < 128) {
                const int b1 = (pm >> 4) + 1;
#pragma unroll
                for (int ai = 0; ai < 2; ++ai)
#pragma unroll
                    for (int m = 0; m < 4; ++m) { const int r = pm * 256 + ai * 128 + m * 16 + lr0;
                        bf16_t* kp = KV + (size_t)(r + 64 * b1) * 1024 + c0; float* fp = op + (size_t)(r + 16 * b1) * 1024 + c0;
#pragma unroll
                        for (int bj = 0; bj < 2; ++bj)
#pragma unroll
                            for (int n = 0; n < 2; ++n) { const f32x4 v = acc[ai][bj][m][n]; *(u32x2*)(kp + bj * 128 + n * 16) = pk4(v); *(f32x4*)(fp + bj * 128 + n * 16) = v; } }
            } else {
#pragma unroll
                for (int m = 0; m < 4; ++m) { const int lr = m * 16 + lr0;
                    bf16_t* kp = KV + (size_t)(KS0 + (m + 4 * wr) * KSR + 1088 + fr) * 1024 + c0; float* fp = os + (size_t)lr * 1024 + c0;
#pragma unroll
                    for (int bj = 0; bj < 2; ++bj)
#pragma unroll
                        for (int n = 0; n < 2; ++n) { const f32x4 v = acc[0][bj][m][n]; *(u32x2*)(kp + bj * 128 + n * 16) = pk4(v); *(f32x4*)(fp + bj * 128 + n * 16) = v; } }
                if (wr == 0) {
                    { bf16_t* kp = KV + (size_t)(MT + fr) * 1024 + c0;
#pragma unroll
                      for (int bj = 0; bj < 2; ++bj)
#pragma unroll
                          for (int n = 0; n < 2; ++n) *(u32x2*)(kp + bj * 128 + n * 16) = pk4(acc[1][bj][0][n]); }
#pragma unroll 1
                    for (int bb = 0; bb < 8; ++bb) { float* fp = op + (size_t)(bb * 4112 + fr) * 1024 + c0;
#pragma unroll
                        for (int bj = 0; bj < 2; ++bj)
#pragma unroll
                            for (int n = 0; n < 2; ++n) *(f32x4*)(fp + bj * 128 + n * 16) = acc[1][bj][0][n]; }
                }
            }
        } else if (pn < 15) {
            const int c0 = (pn - 12) * 256 + lc0;
#pragma unroll
            for (int ai = 0; ai < 2; ++ai)
#pragma unroll
                for (int m = 0; m < 4; ++m) { bf16_t* rp = CQ + (size_t)(pm * 256 + ai * 128 + m * 16 + lr0) * 768 + c0;
#pragma unroll
                    for (int bj = 0; bj < 2; ++bj)
#pragma unroll
                        for (int n = 0; n < 2; ++n) *(u32x2*)(rp + bj * 128 + n * 16) = pk4(acc[ai][bj][m][n]); }
        } else if (pn == 23) {
            const int c0 = 768 + lc0;
#pragma unroll
            for (int ai = 0; ai < 2; ++ai)
#pragma unroll
                for (int m = 0; m < 4; ++m) { float* rp = ZR + (size_t)(pm * 256 + ai * 128 + m * 16 + lr0) * ZRW + c0;
#pragma unroll
                    for (int bj = 0; bj < 2; ++bj)
#pragma unroll
                        for (int n = 0; n < 2; ++n) *(f32x4*)(rp + bj * 128 + n * 16) = acc[ai][bj][m][n]; }
        } else if (pn < 23) {
            const bool isb = pn >= 19; bf16_t* G = isb ? GB : GA; const int c0 = (pn - (isb ? 19 : 15)) * 256 + lc0;
#pragma unroll
            for (int ai = 0; ai < 2; ++ai)
#pragma unroll
                for (int m = 0; m < 4; ++m) { bf16_t* rp = G + (size_t)(pm * 256 + ai * 128 + m * 16 + lr0) * 1024 + c0;
#pragma unroll
                    for (int bj = 0; bj < 2; ++bj)
#pragma unroll
                        for (int n = 0; n < 2; ++n) { const f32x4 z = acc[ai][bj][m][n]; f32x4 sg; sg[0] = sigmoidf_(z[0]); sg[1] = sigmoidf_(z[1]); sg[2] = sigmoidf_(z[2]); sg[3] = sigmoidf_(z[3]);
                            *(u32x2*)(rp + bj * 128 + n * 16) = pk4(sg); } }
        } else {
            if (wc == 0) {
#pragma unroll
                for (int ai = 0; ai < 2; ++ai)
#pragma unroll
                    for (int m = 0; m < 4; ++m) { float* rp = ZR + (size_t)(pm * 256 + ai * 128 + m * 16 + lr0) * ZRW + 1024 + 4 * fq;
#pragma unroll
                        for (int n = 0; n < 2; ++n) *(f32x4*)(rp + n * 16) = acc[ai][0][m][n]; }
            }
        }
    }
};

__device__ __forceinline__ int row_pos(int r) { return r < RP ? (r & 4095) : (r < RS1 ? 1024 + ((r - RS0) & 15) : (r < RM1 ? r - RM0 - 16 : 0)); }

struct EpiUq {
    static constexpr bool PERM = false, AFTER_DRAIN = false;
    bf16_t* QM; const float* RT;
    __device__ __forceinline__ void operator()(const f32x4 (&acc)[2][2][4][2], const Unit& u, int wr, int wc, int fr, int fq) const {
        const int pn = u.pn, pm = u.pm, lr0 = wr * 64 + fr, lc0 = wc * 32 + 4 * fq;
#pragma unroll
        for (int bj = 0; bj < 2; ++bj) {
            const int blk = 8 * pn + 4 * bj + wc; const bool rp = (blk % 3) == 2;
#pragma unroll
            for (int ai = 0; ai < 2; ++ai)
#pragma unroll
                for (int m = 0; m < 4; ++m) { const int r = pm * 256 + ai * 128 + m * 16 + lr0;
                    f32x4 a = acc[ai][bj][m][0], b = acc[ai][bj][m][1];
                    if (rp) { const int pos = row_pos(r); const f32x4* cs = (const f32x4*)(RT + ((size_t)(pos + 16) * 16 + 4 * fq) * 2);
                        const f32x4 c01 = cs[0], c23 = cs[1]; f32x4 na, nb;
                        na[0] = a[0] * c01[0] - b[0] * c01[1]; nb[0] = a[0] * c01[1] + b[0] * c01[0];
                        na[1] = a[1] * c01[2] - b[1] * c01[3]; nb[1] = a[1] * c01[3] + b[1] * c01[2];
                        na[2] = a[2] * c23[0] - b[2] * c23[1]; nb[2] = a[2] * c23[1] + b[2] * c23[0];
                        na[3] = a[3] * c23[2] - b[3] * c23[3]; nb[3] = a[3] * c23[3] + b[3] * c23[2];
                        a = na; b = nb; }
                    bf16_t* op = QM + (size_t)r * 768 + pn * 256 + bj * 128 + lc0;
                    *(u32x2*)(op) = pk4(a * QS_B); *(u32x2*)(op + 16) = pk4(b * QS_B); }
        }
    }
};

struct EpiKv {
    static constexpr bool PERM = true, AFTER_DRAIN = false;
    bf16_t *KM, *VM;
    __device__ __forceinline__ void operator()(const f32x4 (&acc)[2][2][4][2], const Unit& u, int wr, int wc, int fr, int fq) const {
        const int pn = u.pn, pm = u.pm, lr0 = wr * 64 + fr;
        const bool isk = wc < 2; const int pitch = isk ? 768 : 512, hstep = isk ? 96 : 64;
        bf16_t* base = (isk ? KM + wc * 32 : VM + (wc - 2) * 32) + 2 * pn * hstep + 8 * fq;
#define KV_ST(P, A0, A1) do { u32x4 w_; w_.x = pk2((A0)[0], (A0)[1]); w_.y = pk2((A0)[2], (A0)[3]); w_.z = pk2((A1)[0], (A1)[1]); w_.w = pk2((A1)[2], (A1)[3]); *(u32x4*)(P) = w_; } while (0)
        if (pm != 128) {
            const int kb = pm < 128 ? pm * 256 + 64 * ((pm >> 4) + 1) : KS0 + ((pm - 129) >> 2) * KSR + 64 + ((pm - 129) & 3) * 256;
#pragma unroll
            for (int ai = 0; ai < 2; ++ai)
#pragma unroll
                for (int m = 0; m < 4; ++m) { bf16_t* rp = base + (size_t)(kb + ai * 128 + m * 16 + lr0) * pitch;
#pragma unroll
                    for (int bj = 0; bj < 2; ++bj) KV_ST(rp + bj * hstep, acc[ai][bj][m][0], acc[ai][bj][m][1]); }
        } else {
#pragma unroll
            for (int m = 0; m < 4; ++m) { bf16_t* rp = base + (size_t)(KS0 + (m + 4 * wr) * KSR + 1088 + fr) * pitch;
#pragma unroll
                for (int bj = 0; bj < 2; ++bj) KV_ST(rp + bj * hstep, acc[0][bj][m][0], acc[0][bj][m][1]); }
            if (wr == 0) { bf16_t* rp = base + (size_t)(MT + fr) * pitch;
#pragma unroll
                for (int bj = 0; bj < 2; ++bj) KV_ST(rp + bj * hstep, acc[1][bj][0][0], acc[1][bj][0][1]); }
        }
#undef KV_ST
    }
};

struct EpiBrA {
    static constexpr bool PERM = false, AFTER_DRAIN = false;
    const bf16_t* GA; bf16_t* T1;
    __device__ __forceinline__ void operator()(const f32x4 (&acc)[2][2][4][2], const Unit& u, int wr, int wc, int fr, int fq) const {
        const int lr0 = wr * 64 + fr, c0 = u.pn * 256 + wc * 32 + 4 * fq;
#pragma unroll
        for (int ai = 0; ai < 2; ++ai)
#pragma unroll
            for (int m = 0; m < 4; ++m) { const size_t ro = (size_t)(u.pm * 256 + ai * 128 + m * 16 + lr0) * 1024 + c0;
#pragma unroll
                for (int bj = 0; bj < 2; ++bj)
#pragma unroll
                    for (int n = 0; n < 2; ++n) { const f32x4 g = ldbf4(GA + ro + bj * 128 + n * 16); *(u32x2*)(T1 + ro + bj * 128 + n * 16) = pk4(acc[ai][bj][m][n] * g); } }
    }
};
struct EpiBrB {
    static constexpr bool PERM = false, AFTER_DRAIN = false;
    const bf16_t* GB; const bf16_t* T1; bf16_t* MM;
    __device__ __forceinline__ void operator()(const f32x4 (&acc)[2][2][4][2], const Unit& u, int wr, int wc, int fr, int fq) const {
        const int lr0 = wr * 64 + fr, c0 = u.pn * 256 + wc * 32 + 4 * fq;
#pragma unroll
        for (int ai = 0; ai < 2; ++ai)
#pragma unroll
            for (int m = 0; m < 4; ++m) { const size_t ro = (size_t)(u.pm * 256 + ai * 128 + m * 16 + lr0) * 1024 + c0;
#pragma unroll
                for (int bj = 0; bj < 2; ++bj)
#pragma unroll
                    for (int n = 0; n < 2; ++n) { const f32x4 g = ldbf4(GB + ro + bj * 128 + n * 16), t = ldbf4(T1 + ro + bj * 128 + n * 16); *(u32x2*)(MM + ro + bj * 128 + n * 16) = pk4(t + acc[ai][bj][m][n] * g); } }
    }
};
struct EpiRes {
    static constexpr bool PERM = false, AFTER_DRAIN = false;
    bf16_t* H; int ntf; float* PART;
    __device__ __forceinline__ void operator()(const f32x4 (&acc)[2][2][4][2], const Unit& u, int wr, int wc, int fr, int fq) const {
        const int lr0 = wr * 64 + fr, c0 = u.pn * 256 + wc * 32 + 4 * fq;
        if (u.nt == ntf) {
#pragma unroll
            for (int ai = 0; ai < 2; ++ai)
#pragma unroll
                for (int m = 0; m < 4; ++m) { bf16_t* rp = H + (size_t)(u.pm * 256 + ai * 128 + m * 16 + lr0) * 1024 + c0;
#pragma unroll
                    for (int bj = 0; bj < 2; ++bj)
#pragma unroll
                        for (int n = 0; n < 2; ++n) { bf16_t* q = rp + bj * 128 + n * 16; *(u32x2*)q = pk4(ldbf4(q) + acc[ai][bj][m][n]); } }
        } else {
            const int ks = u.k0 / (u.nt * 64);
#pragma unroll
            for (int ai = 0; ai < 2; ++ai)
#pragma unroll
                for (int m = 0; m < 4; ++m) { float* rp = PART + ((size_t)ks * 256 + ai * 128 + m * 16 + lr0) * 1024 + c0;
#pragma unroll
                    for (int bj = 0; bj < 2; ++bj)
#pragma unroll
                        for (int n = 0; n < 2; ++n) *(f32x4*)(rp + bj * 128 + n * 16) = acc[ai][bj][m][n]; }
        }
    }
};
struct EpiUp {
    static constexpr bool PERM = true, AFTER_DRAIN = false;
    bf16_t* U; float *cvp, *cvs;
    __device__ __forceinline__ void operator()(const f32x4 (&acc)[2][2][4][2], const Unit& u, int wr, int wc, int fr, int fq) const {
        const int pm = u.pm, lr0 = wr * 64 + fr, c0 = u.pn * 256 + wc * 32 + 8 * fq;
#pragma unroll
        for (int ai = 0; ai < 2; ++ai)
#pragma unroll
            for (int m = 0; m < 4; ++m) { const int lr = ai * 128 + m * 16 + lr0; bf16_t* rp = U + (size_t)(pm * 256 + lr) * DFF2 + c0;
                float* cv = nullptr;
                if (pm < 128) { if ((pm & 15) == 15 && lr >= 254) cv = cvp + (size_t)((pm >> 4) * 2 + (lr - 254)) * DFF2; }
                else if (lr < 128 && (lr & 15) >= 14) cv = cvs + (size_t)((lr >> 4) * 2 + ((lr & 15) - 14)) * DFF2;
#pragma unroll
                for (int bj = 0; bj < 2; ++bj) { const f32x4 v0 = acc[ai][bj][m][0], v1 = acc[ai][bj][m][1]; u32x4 w; w.x = pk2(v0[0], v0[1]); w.y = pk2(v0[2], v0[3]); w.z = pk2(v1[0], v1[1]); w.w = pk2(v1[2], v1[3]);
                    *(u32x4*)(rp + bj * 128) = w;
                    if (cv) { *(f32x4*)(cv + c0 + bj * 128) = v0; *(f32x4*)(cv + c0 + bj * 128 + 4) = v1; } } }
    }
};
__device__ __forceinline__ void transpose_item(const float* W, int K, int N, bf16_t* WT, int k0, int n0, int drow0, LAS float* scr, int lane) {
#pragma unroll 8
    for (int i = 0; i < 32; ++i) { const int kk = 2 * i + (lane >> 5); scr[kk * 33 + (lane & 31)] = W[(size_t)(k0 + kk) * N + n0 + (lane & 31)]; }
    LDS_WAIT();
    const int c = lane & 7;
#pragma unroll
    for (int j = 0; j < 4; ++j) { const int n = (lane >> 3) + 8 * j; const LAS float* s = scr + (8 * c) * 33 + n;
        u32x4 o; o.x = pk2(s[0 * 33], s[1 * 33]); o.y = pk2(s[2 * 33], s[3 * 33]); o.z = pk2(s[4 * 33], s[5 * 33]); o.w = pk2(s[6 * 33], s[7 * 33]);
        *(u32x4*)(WT + (size_t)(drow0 + n) * K + k0 + 8 * c) = o; }
    LDS_WAIT();
}
__device__ __forceinline__ void conv_row_bf16(const float* src, bf16_t* dst, int lane) {
#pragma unroll
    for (int j = 0; j < 4; ++j) { const f32x4 v = ((const f32x4*)src)[lane + 64 * j]; ((u32x2*)dst)[lane + 64 * j] = pk4(v); }
}

__device__ __forceinline__ void phase_prologue(KP p, LAS unsigned char* lds, int gw, int NGW, int wave, int lane) {
    unsigned char* ws = p->ws;
    LAS float* scr = (LAS float*)(lds + wave * 8448);
    constexpr int I_IN = 16 * 193, I_UQ = 12 * 24, I_UKV = 4 * 32, I_A = 16 * 32, I_B = 8 * 32, I_O = 16 * 32, I_UP = 16 * 176, I_D = 44 * 32;
    constexpr int I_L = I_IN + I_UQ + I_UKV + I_A + I_B + I_O + I_UP + I_D;
    for (int it = gw; it < 4 * I_L; it += NGW) {
        const int l = it / I_L; int r = it - l * I_L; bf16_t* WT = (bf16_t*)(ws + W_WT) + (size_t)l * WL;
        if (r < I_IN) { const int kb = r / 193, nb = r - kb * 193, n0 = nb * 32; const int d0 = n0 < 3840 ? n0 : (n0 < 4128 ? 5888 + (n0 - 3840) : n0 - 288);
            transpose_item(p->in[10] + (size_t)l * 1024 * NIN, 1024, NIN, WT + WO_IN, kb * 64, n0, d0, scr, lane); continue; } r -= I_IN;
        if (r < I_UQ) { const int kb = r / 24, nb = r - kb * 24; transpose_item(p->in[14] + (size_t)l * 768 * 768, 768, 768, WT + WO_UQ, kb * 64, nb * 32, nb * 32, scr, lane); continue; } r -= I_UQ;
        if (r < I_UKV) { const int kb = r / 32, nb = r & 31; transpose_item(p->in[16] + (size_t)l * 256 * 1024, 256, 1024, WT + WO_UKV, kb * 64, nb * 32, nb * 32, scr, lane); continue; } r -= I_UKV;
        if (r < I_A) { const int kb = r / 32, nb = r & 31; transpose_item(p->in[17] + (size_t)l * 1024 * 1024, 1024, 1024, WT + WO_A, kb * 64, nb * 32, nb * 32, scr, lane); continue; } r -= I_A;
        if (r < I_B) { const int kb = r / 32, nb = r & 31; transpose_item(p->in[18] + (size_t)l * 512 * 1024, 512, 1024, WT + WO_B, kb * 64, nb * 32, nb * 32, scr, lane); continue; } r -= I_B;
        if (r < I_O) { const int kb = r / 32, nb = r & 31; transpose_item(p->in[19] + (size_t)l * 1024 * 1024, 1024, 1024, WT + WO_O, kb * 64, nb * 32, nb * 32, scr, lane); continue; } r -= I_O;
        if (r < I_UP) { const int kb = r / 176, nb = r - kb * 176; transpose_item(p->in[21] + (size_t)l * 1024 * DFF2, 1024, DFF2, WT + WO_UP, kb * 64, nb * 32, nb * 32, scr, lane); continue; } r -= I_UP;
        { const int kb = r / 32, nb = r & 31; transpose_item(p->in[24] + (size_t)l * DFF * 1024, DFF, 1024, WT + WO_D, kb * 64, nb * 32, nb * 32, scr, lane); }
    }
    const int gt = gw * 64 + lane, NGT = NGW * 64;
    float* LUT = (float*)(ws + W_LUT); float* LAM = (float*)(ws + W_LAM); float* RT = (float*)(ws + W_RT);
    for (int i = gt; i < 8 * 192; i += NGT) { const int h = i / 192, rel = (i - h * 192) - 128; const int n = rel < 0 ? -rel : rel; int bk;
        if (n < 8) bk = n; else { const int k = (31 - __clz(n * n)) - 6; bk = 8 + k; if (bk > 15) bk = 15; }
        if (rel > 0) bk += 16;
        LUT[i] = p->in[8][bk * 8 + h] * LOG2E; }
    if (gt < 4) { const float* al = p->in[11] + gt * 256; float s1 = 0.f, s2 = 0.f; for (int i = 0; i < 64; ++i) { s1 += al[i] * al[64 + i]; s2 += al[128 + i] * al[192 + i]; }
        LAM[gt] = expf(s1) - expf(s2) + (0.8f - 0.6f * expf(-0.3f * (float)gt)); }
    for (int i = gt; i < 4128 * 16; i += NGT) { const int pi = i >> 4, k = i & 15; const float ang = (float)(pi - 16) * ROPE_INV[k];
        const double a = (double)ang * 0.15915494309189535; const double fr = a - rint(a); const float f = (float)fr * 6.283185307179586f;
        RT[2 * i] = cosf(f); RT[2 * i + 1] = sinf(f); }
}

__device__ __forceinline__ void phase_norm(KP p, int l, const float* g, int gw, int NGW, int lane, bool first, int nparts) {
    unsigned char* ws = p->ws; bf16_t* H = (bf16_t*)(ws + W_H); bf16_t* XN = (bf16_t*)(ws + W_XN); const float* PART = (const float*)(ws + W_PART);
    f32x4 gv[4];
#pragma unroll
    for (int j = 0; j < 4; ++j) gv[j] = ((const f32x4*)g)[lane + 64 * j];
    for (int r = gw; r < RM1; r += NGW) {
        f32x4 v[4]; float ss = 0.f;
        if (first) { const float* src = r < RP ? p->in[0] + (size_t)r * 1024 : (r < RS1 ? p->in[1] + (size_t)(r - RS0) * 1024 : p->in[7] + (size_t)(r - RM0) * 1024);
#pragma unroll
            for (int j = 0; j < 4; ++j) v[j] = ((const f32x4*)src)[lane + 64 * j]; }
        else {
#pragma unroll
            for (int j = 0; j < 4; ++j) v[j] = ldbf4(H + (size_t)r * 1024 + (lane + 64 * j) * 4); }
        const bool fold = (r >= RP) && nparts > 0;
        if (fold) {
#pragma unroll 1
            for (int k = 0; k < nparts; ++k) { const f32x4* pp = (const f32x4*)(PART + ((size_t)k * 256 + (r - RP)) * 1024);
#pragma unroll
                for (int j = 0; j < 4; ++j) v[j] = v[j] + pp[lane + 64 * j]; } }
#pragma unroll
        for (int j = 0; j < 4; ++j) ss += (v[j][0] * v[j][0] + v[j][1] * v[j][1]) + (v[j][2] * v[j][2] + v[j][3] * v[j][3]);
        const float rstd = 1.0f / sqrtf(wave_sum(ss, lane) * (1.f / 1024.f) + EPS);
#pragma unroll
        for (int j = 0; j < 4; ++j) { if (first || fold) ((u32x2*)(H + (size_t)r * 1024))[lane + 64 * j] = pk4(v[j]);
            ((u32x2*)(XN + (size_t)r * 1024))[lane + 64 * j] = pk4(v[j] * rstd * gv[j]); }
    }
}
__device__ __forceinline__ void phase_cache_conv(KP p, int l, int gw, int NGW, int lane) {
    unsigned char* ws = p->ws; bf16_t* KA = (bf16_t*)(ws + W_KA); bf16_t* VA = (bf16_t*)(ws + W_VA);
    for (int i = gw; i < 16384; i += NGW) { const int which = i >> 13, rr = i & 8191, b = rr >> 10, pp = rr & 1023;
        const float* src = p->in[which ? 3 : 2] + ((size_t)(l * 8 + b) * 1024 + pp) * 1024;
        conv_row_bf16(src, (which ? VA : KA) + (size_t)(KS0 + b * KSR + 64 + pp) * 1024, lane); }
}
__device__ __forceinline__ void phase_final(KP p, int gw, int NGW, int lane) {
    const bf16_t* H = (const bf16_t*)(p->ws + W_H); const float* g = p->in[25];
    for (int r = gw; r < RS1; r += NGW) {
        const bf16_t* src = H + (size_t)r * 1024; float* dst = p->out + (r < RP ? O_YP + (size_t)r * 1024 : O_YS + (size_t)(r - RS0) * 1024);
        f32x4 v[4]; float ss = 0.f;
#pragma unroll
        for (int j = 0; j < 4; ++j) v[j] = ldbf4(src + (lane + 64 * j) * 4);
        if (r >= RP) {
#pragma unroll 1
            for (int k = 0; k < 11; ++k) { const f32x4* pp = (const f32x4*)((const float*)(p->ws + W_PART) + ((size_t)k * 256 + (r - RP)) * 1024);
#pragma unroll
                for (int j = 0; j < 4; ++j) v[j] = v[j] + pp[lane + 64 * j]; } }
#pragma unroll
        for (int j = 0; j < 4; ++j) ss += (v[j][0] * v[j][0] + v[j][1] * v[j][1]) + (v[j][2] * v[j][2] + v[j][3] * v[j][3]);
        const float rstd = 1.0f / sqrtf(wave_sum(ss, lane) * (1.f / 1024.f) + EPS);
#pragma unroll
        for (int j = 0; j < 4; ++j) ((f32x4*)dst)[lane + 64 * j] = v[j] * rstd * ((const f32x4*)g)[lane + 64 * j];
    }
}

__device__ __forceinline__ void kpe_store(bf16_t* KM, int krow, int lane, unsigned short v1, unsigned short v2) {
    const int i = lane & 15, hs = lane >> 4; bf16_t* rp = KM + (size_t)krow * 768 + 64 + i;
    rp[hs * 96] = v1; rp[hs * 96 + 16] = v2; rp[(hs + 4) * 96] = v1; rp[(hs + 4) * 96 + 16] = v2;
}
__device__ __forceinline__ void phase_mlaprep(KP p, int l, int gw, int NGW, int lane) {
    unsigned char* ws = p->ws; const float* ZR = (const float*)(ws + W_ZR); bf16_t* CQN = (bf16_t*)(ws + W_CQN); bf16_t* CKVA = (bf16_t*)(ws + W_CKVA); bf16_t* KM = (bf16_t*)(ws + W_KM);
    const float* RT = (const float*)(ws + W_RT);
    const float* gq = p->in[13] + l * 768; const float* gkv = p->in[15] + l * 256;
    float* ckp = p->out + O_CKP + (size_t)l * 8 * 4112 * 256; float* cks = p->out + O_CKS + (size_t)l * 128 * 256;
    float* krp = p->out + O_KRP + (size_t)l * 8 * 4112 * 32; float* krs = p->out + O_KRS + (size_t)l * 128 * 32;
    for (int r = gw; r < RM1; r += NGW) {
        const float* z = ZR + (size_t)r * ZRW;
        { f32x4 v[3]; float ss = 0.f; bf16_t* cq = CQN + (size_t)r * 768;
#pragma unroll
          for (int j = 0; j < 3; ++j) { v[j] = ldbf4(cq + (lane + 64 * j) * 4); ss += (v[j][0] * v[j][0] + v[j][1] * v[j][1]) + (v[j][2] * v[j][2] + v[j][3] * v[j][3]); }
          const float rstd = 1.0f / sqrtf(wave_sum(ss, lane) * (1.f / 768.f) + EPS);
#pragma unroll
          for (int j = 0; j < 3; ++j) ((u32x2*)cq)[lane + 64 * j] = pk4(v[j] * rstd * ((const f32x4*)gq)[lane + 64 * j]); }
        { f32x4 v = ((const f32x4*)(z + 768))[lane]; const float ss = (v[0] * v[0] + v[1] * v[1]) + (v[2] * v[2] + v[3] * v[3]);
          const float rstd = 1.0f / sqrtf(wave_sum(ss, lane) * (1.f / 256.f) + EPS);
          v = v * rstd * ((const f32x4*)gkv)[lane];
          ((u32x2*)(CKVA + (size_t)r * 256))[lane] = pk4(v);
          if (r < RP) { const int b = r >> 12, t = r & 4095; ((f32x4*)(ckp + (size_t)(b * 4112 + 16 + t) * 256))[lane] = v; }
          else if (r < RS1) ((f32x4*)(cks + (size_t)(r - RS0) * 256))[lane] = v;
          else { const int j = r - RM0;
#pragma unroll 1
              for (int bb = 0; bb < 8; ++bb) ((f32x4*)(ckp + (size_t)(bb * 4112 + j) * 256))[lane] = v; } }
        { const int i = lane & 15; const float x1 = z[1024 + i], x2 = z[1040 + i]; const int pos = row_pos(r);
          const float c = RT[((size_t)(pos + 16) * 16 + i) * 2], s = RT[((size_t)(pos + 16) * 16 + i) * 2 + 1];
          const float o1 = x1 * c - x2 * s, o2 = x1 * s + x2 * c;
          const unsigned pk = pk2(o1, o2); const unsigned short b1 = (unsigned short)(pk & 0xffffu), b2 = (unsigned short)(pk >> 16);
          if (r < RP) { const int b = r >> 12, t = r & 4095; if (lane < 16) { float* o = krp + (size_t)(b * 4112 + 16 + t) * 32; o[i] = o1; o[16 + i] = o2; } kpe_store(KM, b * KPR + 64 + t, lane, b1, b2); }
          else if (r < RS1) { const int q = r - RS0; if (lane < 16) { float* o = krs + (size_t)q * 32; o[i] = o1; o[16 + i] = o2; } kpe_store(KM, KS0 + (q >> 4) * KSR + 1088 + (q & 15), lane, b1, b2); }
          else { const int j = r - RM0;
#pragma unroll 1
              for (int bb = 0; bb < 8; ++bb) { if (lane < 16) { float* o = krp + (size_t)(bb * 4112 + j) * 32; o[i] = o1; o[16 + i] = o2; } }
              kpe_store(KM, MT + j, lane, b1, b2); } }
    }
    const float* cck = p->in[4] + (size_t)l * RC * 256; const float* ckr = p->in[5] + (size_t)l * RC * 32;
    for (int i = gw; i < RC; i += NGW) {
        const f32x4 v = ((const f32x4*)(cck + (size_t)i * 256))[lane]; ((u32x2*)(CKVA + (size_t)(R + i) * 256))[lane] = pk4(v);
        const int k = lane & 15; const unsigned pk = pk2(ckr[(size_t)i * 32 + k], ckr[(size_t)i * 32 + 16 + k]);
        kpe_store(KM, KS0 + (i >> 10) * KSR + 64 + (i & 1023), lane, (unsigned short)(pk & 0xffffu), (unsigned short)(pk >> 16));
    }
}

__device__ __forceinline__ void phase_conv(KP p, int l, int gw, int NGW, int lane) {
    unsigned char* ws = p->ws; const bf16_t* U = (const bf16_t*)(ws + W_U); bf16_t* ACT = (bf16_t*)(ws + W_ACT);
    const float* cw = p->in[22] + (size_t)l * 3 * DFF2; const float* cb = p->in[23] + (size_t)l * DFF2; const float* st = p->in[6] + (size_t)l * 8 * 2 * DFF2;
    constexpr int NRB = RM1 / 16;
    for (int it = gw; it < NRB * 11; it += NGW) {
        const int rbi = it / 11, sl = it - rbi * 11, rb = NRB - 1 - rbi, r0 = rb * 16, f = sl * 256 + lane * 4;
        const f32x4 wa0 = *(const f32x4*)(cw + f), wa1 = *(const f32x4*)(cw + DFF2 + f), wa2 = *(const f32x4*)(cw + 2 * DFF2 + f), ba = *(const f32x4*)(cb + f);
        const f32x4 wg0 = *(const f32x4*)(cw + DFF + f), wg1 = *(const f32x4*)(cw + DFF2 + DFF + f), wg2 = *(const f32x4*)(cw + 2 * DFF2 + DFF + f), bg = *(const f32x4*)(cb + DFF + f);
        f32x4 a2, a1, g2, g1;
        if (r0 < RP) { if ((r0 & 4095) == 0) { const bf16_t* m0 = U + (size_t)(RM0 + 14) * DFF2; a2 = ldbf4(m0 + f); g2 = ldbf4(m0 + DFF + f); a1 = ldbf4(m0 + DFF2 + f); g1 = ldbf4(m0 + DFF2 + DFF + f); }
                       else { const bf16_t* m0 = U + (size_t)(r0 - 2) * DFF2; a2 = ldbf4(m0 + f); g2 = ldbf4(m0 + DFF + f); a1 = ldbf4(m0 + DFF2 + f); g1 = ldbf4(m0 + DFF2 + DFF + f); } }
        else if (r0 < RS1) { const float* s0 = st + (size_t)((r0 - RS0) >> 4) * 2 * DFF2; a2 = *(const f32x4*)(s0 + f); g2 = *(const f32x4*)(s0 + DFF + f); a1 = *(const f32x4*)(s0 + DFF2 + f); g1 = *(const f32x4*)(s0 + DFF2 + DFF + f); }
        else { a2 = (f32x4){0.f, 0.f, 0.f, 0.f}; a1 = a2; g2 = a2; g1 = a2; }
#pragma unroll 4
        for (int i = 0; i < 16; ++i) { const bf16_t* ur = U + (size_t)(r0 + i) * DFF2; const f32x4 a0 = ldbf4(ur + f), g0 = ldbf4(ur + DFF + f);
            const f32x4 ca = ba + wa0 * a2 + wa1 * a1 + wa2 * a0, cg = bg + wg0 * g2 + wg1 * g1 + wg2 * g0; f32x4 o;
            o[0] = ca[0] * cg[0] / (1.f + __expf(-cg[0])); o[1] = ca[1] * cg[1] / (1.f + __expf(-cg[1])); o[2] = ca[2] * cg[2] / (1.f + __expf(-cg[2])); o[3] = ca[3] * cg[3] / (1.f + __expf(-cg[3]));
            *(u32x2*)(ACT + (size_t)(r0 + i) * DFF + f) = pk4(o);
            a2 = a1; a1 = a0; g2 = g1; g1 = g0; }
    }
}
template <bool DIFF>
__device__ __forceinline__ void attn_unit(LAS unsigned char* lds, const bf16_t* Qg, const bf16_t* Kg, const bf16_t* Vg, bf16_t* Og,
        const int kbase, const int hx, const int NT, const int lastv, const int qrow_w, const int qpos_w, const int nqv, const int nt_w,
        const float* lutg, const float lam, const float oscale, const float* subg) {
    constexpr int DQK = DIFF ? 64 : 96, NS = DQK / 16, NDB = DIFF ? 4 : 2;
    constexpr int KCH = DQK / 4, KROWB = DQK * 4 + 16, VROWB = 320, KTILEB = 64 * KROWB, VTILEB = 64 * VROWB, BUFB = KTILEB + VTILEB, NKC = 64 * KCH / 512;
    constexpr int KP = DIFF ? 1024 : 768, VP = DIFF ? 1024 : 512;
    constexpr int LUT_OFF = 98304;
    const int tid = tid_fresh(), lane = tid & 63, wid = __builtin_amdgcn_readfirstlane(tid >> 6), s = wid >> 2, l32 = lane & 31, hi = lane >> 5;
    const int kcol0 = hx * (2 * DQK), vcol0 = hx * 128, sdv = DIFF ? 0 : s * 64;
    LAS float* lut = (LAS float*)(lds + LUT_OFF);
    u32x4 kst[NKC], vst[2];
#define ATT_GLOAD(t) do { \
    _Pragma("unroll") for (int i_ = 0; i_ < NKC; ++i_) { const int c_ = tid + 512 * i_, row_ = c_ / KCH, cc_ = c_ - row_ * KCH; kst[i_] = *(const u32x4*)(Kg + (size_t)(((t) == 0 ? MT : kbase + (t) * 64) + row_) * KP + kcol0 + cc_ * 8); } \
    _Pragma("unroll") for (int i_ = 0; i_ < 2; ++i_) { const int c_ = tid + 512 * i_, row_ = c_ >> 4, cc_ = c_ & 15; vst[i_] = *(const u32x4*)(Vg + (size_t)(((t) == 0 ? MT : kbase + (t) * 64) + row_) * VP + vcol0 + cc_ * 8); } } while (0)
#define ATT_LSTORE(b) do { \
    _Pragma("unroll") for (int i_ = 0; i_ < NKC; ++i_) { const int c_ = tid + 512 * i_, row_ = c_ / KCH, cc_ = c_ - row_ * KCH; *(LAS u32x4*)(lds + (b) * BUFB + row_ * KROWB + cc_ * 16) = kst[i_]; } \
    _Pragma("unroll") for (int i_ = 0; i_ < 2; ++i_) { const int c_ = tid + 512 * i_, row_ = c_ >> 4, cc_ = c_ & 15; *(LAS u32x4*)(lds + (b) * BUFB + KTILEB + row_ * VROWB + cc_ * 16) = vst[i_]; } } while (0)
    ATT_GLOAD(0);
    if (DIFF) { if (tid < 192) lut[tid] = lutg[hx * 192 + tid] - lutg[hx * 192]; }
    bf16x8 qf[NS];
    { const int qi = l32 < nqv ? l32 : (nqv > 0 ? nqv - 1 : 0);
      const bf16_t* qp = Qg + (size_t)(qrow_w + qi) * KP + (DIFF ? hx * 128 + s * 64 : (hx * 2 + s) * 96) + hi * 8;
#pragma unroll
      for (int st = 0; st < NS; ++st) qf[st] = *(const bf16x8*)(qp + st * 16); }
    f32x16 o[NDB];
#pragma unroll
    for (int db = 0; db < NDB; ++db)
#pragma unroll
        for (int r = 0; r < 16; ++r) o[db][r] = 0.f;
    float mrun = 0.f, lsum = 0.f; f32x16 negm;
#pragma unroll
    for (int r = 0; r < 16; ++r) negm[r] = 0.f;
    ATT_LSTORE(0);
    __syncthreads();
    const int qpos = qpos_w + l32;
    for (int t = 0; t < NT; ++t) {
        const int buf = t & 1;
        if (t + 1 < NT) ATT_GLOAD(t + 1);
        if (t < nt_w) {
            const LAS unsigned char* kb_ = lds + buf * BUFB; const LAS unsigned char* vb_ = kb_ + KTILEB;
            f32x16 pr[2];
            const LAS unsigned char* vbase = vb_ + (4 * hi + ((lane & 15) >> 2)) * VROWB + (sdv + ((lane >> 4) & 1) * 16 + (lane & 3) * 4) * 2;
#define VLOAD(dst, g) do { _Pragma("unroll") for (int db_ = 0; db_ < NDB; ++db_) { const LAS unsigned char* va_ = vbase + ((g) * 16) * VROWB + db_ * 64; \
                const v4i16_t t1_ = __builtin_amdgcn_ds_read_tr16_b64_v4i16((LAS v4i16_t*)va_); const v4i16_t t2_ = __builtin_amdgcn_ds_read_tr16_b64_v4i16((LAS v4i16_t*)(va_ + 8 * VROWB)); \
                dst[db_] = __builtin_shufflevector(t1_, t2_, 0, 1, 2, 3, 4, 5, 6, 7); } } while (0)
#define PVMMA(src, g) do { u32x4 pw_; pw_.x = pk2(pr[(g) >> 1][8 * ((g) & 1) + 0], pr[(g) >> 1][8 * ((g) & 1) + 1]); pw_.y = pk2(pr[(g) >> 1][8 * ((g) & 1) + 2], pr[(g) >> 1][8 * ((g) & 1) + 3]); \
                pw_.z = pk2(pr[(g) >> 1][8 * ((g) & 1) + 4], pr[(g) >> 1][8 * ((g) & 1) + 5]); pw_.w = pk2(pr[(g) >> 1][8 * ((g) & 1) + 6], pr[(g) >> 1][8 * ((g) & 1) + 7]); const bf16x8 pf_ = __builtin_bit_cast(bf16x8, pw_); \
                _Pragma("unroll") for (int db_ = 0; db_ < NDB; ++db_) o[db_] = __builtin_amdgcn_mfma_f32_32x32x16_bf16(src[db_], pf_, o[db_], 0, 0, 0); } while (0)
            bf16x8 vfa[NDB], vfb[NDB];
            {
                bf16x8 kf[2][NS];
#pragma unroll
                for (int kb = 0; kb < 2; ++kb)
#pragma unroll
                    for (int st = 0; st < NS; ++st) kf[kb][st] = *(const LAS bf16x8*)(kb_ + (kb * 32 + l32) * KROWB + (s * DQK + st * 16 + hi * 8) * 2);
                VLOAD(vfa, 0);
                __builtin_amdgcn_sched_barrier(0);
#pragma unroll
                for (int st = 0; st < NS; ++st) {
                    pr[0] = __builtin_amdgcn_mfma_f32_32x32x16_bf16(kf[0][st], qf[st], st == 0 ? negm : pr[0], 0, 0, 0);
                    pr[1] = __builtin_amdgcn_mfma_f32_32x32x16_bf16(kf[1][st], qf[st], st == 0 ? negm : pr[1], 0, 0, 0); }
            }
            const int tp0 = (t == 0) ? -16 : (t - 1) * 64;
            if (DIFF) {
                if (tp0 + 63 - qpos_w > -128) {
#pragma unroll
                    for (int kb = 0; kb < 2; ++kb)
#pragma unroll
                        for (int r = 0; r < 16; ++r) { const int kvi = kb * 32 + 8 * (r >> 2) + 4 * hi + (r & 3); int idx = tp0 + kvi - qpos + 128; idx = idx < 0 ? 0 : idx; pr[kb][r] += lut[idx]; }
                }
            }
            const int nval = (t == 0) ? 16 : (t == NT - 1 ? lastv : 64);
            if (nval < 64) {
#pragma unroll
                for (int kb = 0; kb < 2; ++kb)
#pragma unroll
                    for (int r = 0; r < 16; ++r) { const int kvi = kb * 32 + 8 * (r >> 2) + 4 * hi + (r & 3); if (kvi >= nval) pr[kb][r] = -INFINITY; }
            }
            float mx;
            { float a0 = fmaxf(fmaxf(pr[0][0], pr[0][1]), pr[0][2]), a1 = fmaxf(fmaxf(pr[1][0], pr[1][1]), pr[1][2]);
#pragma unroll
              for (int r = 3; r < 15; r += 2) { a0 = fmaxf(fmaxf(a0, pr[0][r]), pr[0][r + 1]); a1 = fmaxf(fmaxf(a1, pr[1][r]), pr[1][r + 1]); }
              mx = fmaxf(fmaxf(a0, a1), fmaxf(pr[0][15], pr[1][15])); }
            mx = fmaxf(mx, shx(mx, 32, lane));
            if (t == 0 || __any(mx > 8.0f)) {
                const float dl = (t == 0) ? mx : fmaxf(mx, 0.f);
                mrun += dl;
#pragma unroll
                for (int r = 0; r < 16; ++r) negm[r] = -mrun;
                const float alpha = (t == 0) ? 1.f : __builtin_amdgcn_exp2f(-dl); lsum *= alpha;
#pragma unroll
                for (int kb = 0; kb < 2; ++kb) pr[kb] = pr[kb] - dl;
#pragma unroll
                for (int db = 0; db < NDB; ++db) o[db] = o[db] * alpha;
            }
            f32x2 ps2 = (f32x2){0.f, 0.f};
#pragma unroll
            for (int kb = 0; kb < 2; ++kb)
#pragma unroll
                for (int r = 0; r < 16; r += 2) { const float e0 = __builtin_amdgcn_exp2f(pr[kb][r]), e1 = __builtin_amdgcn_exp2f(pr[kb][r + 1]); pr[kb][r] = e0; pr[kb][r + 1] = e1; ps2 += (f32x2){e0, e1}; }
            lsum += ps2[0] + ps2[1];
            __builtin_amdgcn_sched_barrier(0);
            VLOAD(vfb, 1); __builtin_amdgcn_sched_barrier(0); PVMMA(vfa, 0); __builtin_amdgcn_sched_barrier(0);
            VLOAD(vfa, 2); __builtin_amdgcn_sched_barrier(0); PVMMA(vfb, 1); __builtin_amdgcn_sched_barrier(0);
            VLOAD(vfb, 3); __builtin_amdgcn_sched_barrier(0); PVMMA(vfa, 2); __builtin_amdgcn_sched_barrier(0);
            PVMMA(vfb, 3);
#undef VLOAD
#undef PVMMA
        }
        if (t + 1 < NT) ATT_LSTORE(buf ^ 1);
        __syncthreads();
    }
#undef ATT_GLOAD
#undef ATT_LSTORE
    const float ltot = lsum + shx(lsum, 32, lane); const float inv = 1.f / ltot;
    if (DIFF) {
        LAS float* X = (LAS float*)lds;
        if (s == 1) {
#pragma unroll
            for (int db = 0; db < NDB; ++db)
#pragma unroll
                for (int r = 0; r < 16; ++r) X[(db * 16 + r) * 256 + (wid & 3) * 64 + lane] = o[db][r] * inv;
        }
        __syncthreads();
        if (s == 0) {
            float ss = 0.f;
#pragma unroll
            for (int db = 0; db < NDB; ++db)
#pragma unroll
                for (int r = 0; r < 16; ++r) { const float v = o[db][r] * inv - lam * X[(db * 16 + r) * 256 + (wid & 3) * 64 + lane]; o[db][r] = v; ss += v * v; }
            ss += shx(ss, 32, lane);
            const float rstd = oscale / sqrtf(ss * (1.f / 128.f) + EPS);
            if (l32 < nqv) {
                bf16_t* op = Og + (size_t)(qrow_w + l32) * 1024 + hx * 128 + 4 * hi;
#pragma unroll
                for (int db = 0; db < NDB; ++db)
#pragma unroll
                    for (int g4 = 0; g4 < 4; ++g4) { const f32x4 gv = *(const f32x4*)(subg + db * 32 + 8 * g4 + 4 * hi); f32x4 v;
                        v[0] = o[db][4 * g4] * rstd * gv[0]; v[1] = o[db][4 * g4 + 1] * rstd * gv[1]; v[2] = o[db][4 * g4 + 2] * rstd * gv[2]; v[3] = o[db][4 * g4 + 3] * rstd * gv[3];
                        *(u32x2*)(op + db * 32 + 8 * g4) = pk4(v); }
            }
        }
        __syncthreads();
    } else {
        if (l32 < nqv) {
            bf16_t* op = Og + (size_t)(qrow_w + l32) * 512 + (hx * 2 + s) * 64 + 4 * hi;
#pragma unroll
            for (int db = 0; db < NDB; ++db)
#pragma unroll
                for (int g4 = 0; g4 < 4; ++g4) { f32x4 v; v[0] = o[db][4 * g4] * inv; v[1] = o[db][4 * g4 + 1] * inv; v[2] = o[db][4 * g4 + 2] * inv; v[3] = o[db][4 * g4 + 3] * inv;
                    *(u32x2*)(op + db * 32 + 8 * g4) = pk4(v); }
        }
    }
}

template <bool DIFF>
__device__ __forceinline__ void attn_dispatch(LAS unsigned char* lds, KP p, int l, int type, int b, int hx, int j) {
    unsigned char* ws = p->ws;
    const int wid = __builtin_amdgcn_readfirstlane(tid_fresh() >> 6), qg = wid & 3;
    int NT, lastv = 64, kbase, qrow_w = 0, qpos_w = 0, nqv = 0, nt_w = 0;
    if (type == 0) { NT = 2 * j + 3; const int chunk = 2 * j + (qg >> 1); qpos_w = chunk * 64 + (qg & 1) * 32; qrow_w = b * 4096 + qpos_w; nt_w = 2 * j + 2 + (qg >> 1); nqv = 32; kbase = b * KPR; }
    else if (type == 1) { NT = 18; lastv = 16; kbase = KS0 + b * KSR; if (qg == 0) { qrow_w = RS0 + b * 16; qpos_w = 1024; nqv = 16; nt_w = 18; } }
    else { NT = 1; kbase = 0; if (qg == 0) { qrow_w = RM0; qpos_w = -16; nqv = 16; nt_w = 1; } }
    if (DIFF) {
        const float li = 0.8f - 0.6f * expf(-0.3f * (float)l);
        attn_unit<true>(lds, (const bf16_t*)(ws + W_QA), (const bf16_t*)(ws + W_KA), (const bf16_t*)(ws + W_VA), (bf16_t*)(ws + W_OA), kbase, hx, NT, lastv, qrow_w, qpos_w, nqv, nt_w,
                        (const float*)(ws + W_LUT), ((const float*)(ws + W_LAM))[l], 1.f - li, p->in[12] + l * 128);
    } else {
        attn_unit<false>(lds, (const bf16_t*)(ws + W_QM), (const bf16_t*)(ws + W_KM), (const bf16_t*)(ws + W_VM), (bf16_t*)(ws + W_OB), kbase, hx, NT, lastv, qrow_w, qpos_w, nqv, nt_w,
                         nullptr, 0.f, 1.f, nullptr);
    }
}
template <bool DIFF>
__device__ __forceinline__ void attn_phase(LAS unsigned char* lds, KP p, int l, bool with_small) {
    constexpr int NH = DIFF ? 8 : 4, NPAIR = 8 * NH * 16, NSMP = 8 * NH, NMT = NH;
    int cu = blockIdx.x, G = gridDim.x; asm volatile("" : "+s"(cu), "+s"(G));
    const int vcu = (G & 7) == 0 ? (cu & 7) * (G >> 3) + (cu >> 3) : cu;
    const int nit = with_small ? NPAIR + NSMP + NMT : NPAIR;
    for (int it = vcu; it < nit; it += G) {
        if (it < NPAIR) { const int b = it / (NH * 16), hx = (it >> 4) % NH, j = it & 15;
            attn_dispatch<DIFF>(lds, p, l, 0, b, hx, j); attn_dispatch<DIFF>(lds, p, l, 0, b, hx, 31 - j); }
        else if (it < NPAIR + NSMP) { const int i = it - NPAIR; attn_dispatch<DIFF>(lds, p, l, 1, i / NH, i % NH, 0); }
        else attn_dispatch<DIFF>(lds, p, l, 2, 0, it - NPAIR - NSMP, 0);
    }
}
__device__ __forceinline__ void attn_small_diff(LAS unsigned char* lds, KP p, int l, int off) {
    int cu = blockIdx.x, G = gridDim.x; asm volatile("" : "+s"(cu), "+s"(G));
    const int vcu = (G & 7) == 0 ? (cu & 7) * (G >> 3) + (cu >> 3) : cu;
    for (int it = vcu - off; it >= 0 && it < 72; it += G) {
        if (it < 64) attn_dispatch<true>(lds, p, l, 1, it >> 3, it & 7, 0);
        else attn_dispatch<true>(lds, p, l, 2, 0, it - 64, 0);
    }
}

constexpr int LDS_BYTES = 135168;
template <class Epi> __device__ __forceinline__ void run_gemm(LAS unsigned char* lds, const bf16_t* A, const bf16_t* Bt, int M, int N, int K, int c, const Epi& E, int tail_pm = -1, int nsplit = 0) {
    asm volatile("" : "+s"(K));
    pg8::Gemm g{A, Bt, M, N, K}; int G = (int)gridDim.x; asm volatile("" : "+s"(G)); pg8::StaticOrder S; S.init(M, N, G, c, K, tail_pm, nsplit);
    pg8::gemm_phase<Epi, pg8::StaticOrder, true, true>(lds, g, S, E);
}

__global__ void __launch_bounds__(512, 2) fwd_megakernel(Params p_arg) {
    cg::grid_group grid = cg::this_grid();
    extern __shared__ __attribute__((aligned(16))) unsigned char lds_[];
    LAS unsigned char* lds = (LAS unsigned char*)lds_;
    KP kp0 = (KP)__builtin_amdgcn_kernarg_segment_ptr();
#define FRESH() KP p = kp0; asm volatile("" : "+s"(p)); unsigned char* ws = p->ws; (void)ws; const int tid = tid_fresh(), lane = tid & 63, wave = __builtin_amdgcn_readfirstlane(tid >> 6); int cu = blockIdx.x; asm volatile("" : "+s"(cu)); const int gw = cu * 8 + wave; (void)lane; (void)gw
    const int NGW = gridDim.x * 8;
    volatile LAS unsigned* MISC = (volatile LAS unsigned*)(lds + 132096);
    if (threadIdx.x < 16) MISC[threadIdx.x] = 0u;
    __syncthreads();
    const XcdBarrier bar = xcd_barrier_post((unsigned*)(kp0->ws + W_BAR), MISC);
#define GSYNC() xcd_barrier(bar)

    { FRESH(); phase_prologue(p, lds, gw, NGW, wave, lane); }
    grid.sync();
#pragma unroll 1
    for (int l = 0; l < 4; ++l) {
#define WTL ((const bf16_t*)(ws + W_WT) + (size_t)l * WL)
        { FRESH(); phase_norm(p, l, p->in[9] + l * 1024, gw, NGW, lane, l == 0, l == 0 ? 0 : 11); phase_cache_conv(p, l, gw, NGW, lane); }
        GSYNC();
        { FRESH(); EpiIn E{(bf16_t*)(ws + W_QA), (bf16_t*)(ws + W_KA), (bf16_t*)(ws + W_VA), (bf16_t*)(ws + W_GA), (bf16_t*)(ws + W_GB), (float*)(ws + W_ZR),
                  p->out + O_AKP + (size_t)l * 8 * 4112 * 1024, p->out + O_AKS + (size_t)l * 128 * 1024, p->out + O_AVP + (size_t)l * 8 * 4112 * 1024, p->out + O_AVS + (size_t)l * 128 * 1024, (bf16_t*)(ws + W_CQN)};
          run_gemm(lds, (const bf16_t*)(ws + W_XN), WTL + WO_IN, R, NINP, 1024, cu, E); }
        GSYNC();
        { FRESH(); phase_mlaprep(p, l, gw, NGW, lane); }
        __syncthreads();
        { FRESH(); attn_phase<true>(lds, p, l, false); }
        GSYNC();
        { FRESH(); EpiUq E{(bf16_t*)(ws + W_QM), (const float*)(ws + W_RT)}; run_gemm(lds, (const bf16_t*)(ws + W_CQN), WTL + WO_UQ, R, 768, 768, cu, E); }
        { FRESH(); EpiKv E{(bf16_t*)(ws + W_KM), (bf16_t*)(ws + W_VM)}; run_gemm(lds, (const bf16_t*)(ws + W_CKVA), WTL + WO_UKV, RX, 1024, 256, (cu + 128) & 255, E); }
        GSYNC();
        { FRESH(); attn_phase<false>(lds, p, l, true); }
        { FRESH(); attn_small_diff(lds, p, l, 36); }
        GSYNC();
        { FRESH(); EpiBrA E{(const bf16_t*)(ws + W_GA), (bf16_t*)(ws + W_T1)}; run_gemm(lds, (const bf16_t*)(ws + W_OA), WTL + WO_A, R, 1024, 1024, cu, E); }
        { FRESH(); EpiBrB E{(const bf16_t*)(ws + W_GB), (const bf16_t*)(ws + W_T1), (bf16_t*)(ws + W_MM)}; run_gemm(lds, (const bf16_t*)(ws + W_OB), WTL + WO_B, R, 1024, 512, cu, E); }
        GSYNC();
        { FRESH(); EpiRes E{(bf16_t*)(ws + W_H), 16, (float*)(ws + W_PART)}; run_gemm(lds, (const bf16_t*)(ws + W_MM), WTL + WO_O, RP, 1024, 1024, cu, E, 128, 8); }
        GSYNC();
        { FRESH(); phase_norm(p, l, p->in[20] + l * 1024, gw, NGW, lane, false, 8); }
        GSYNC();
        { FRESH(); EpiUp E{(bf16_t*)(ws + W_U), p->out + O_CVP + (size_t)l * 16 * DFF2, p->out + O_CVS + (size_t)l * 16 * DFF2}; run_gemm(lds, (const bf16_t*)(ws + W_XN), WTL + WO_UP, R, DFF2, 1024, cu, E); }
        GSYNC();
        { FRESH(); phase_conv(p, l, gw, NGW, lane); }
        GSYNC();
        { FRESH(); EpiRes E{(bf16_t*)(ws + W_H), DFF / 64, (float*)(ws + W_PART)}; run_gemm(lds, (const bf16_t*)(ws + W_ACT), WTL + WO_D, RP, 1024, DFF, cu, E, 128, 11); }
        GSYNC();
    }
    { FRESH(); phase_final(p, gw, NGW, lane); }
#undef WTL
#undef FRESH
#undef GSYNC
}
}

extern "C" void kernel_launch(void* const* d_in, const int* in_sizes, int n_in, void* d_out, int out_size, void* d_ws, size_t ws_size, hipStream_t stream) {
    static int grid = 0;
    if (!grid) {
        int dev = 0, cus = 0, per = 0;
        if (n_in != 26 || (size_t)out_size != mk::O_END || ws_size < mk::W_END) { fprintf(stderr, "kernel_launch: unexpected shapes (n_in %d out %d ws %zu need %zu)\n", n_in, out_size, ws_size, (size_t)mk::W_END); grid = -1; return; }
        (void)hipGetDevice(&dev); (void)hipDeviceGetAttribute(&cus, hipDeviceAttributeMultiprocessorCount, dev);
        (void)hipFuncSetAttribute((const void*)mk::fwd_megakernel, hipFuncAttributeMaxDynamicSharedMemorySize, mk::LDS_BYTES);
        (void)hipOccupancyMaxActiveBlocksPerMultiprocessor(&per, mk::fwd_megakernel, 512, mk::LDS_BYTES);
        if (per < 1) per = 1;
        grid = cus * per;
    }
    if (grid <= 0) return;
    mk::Params p{};
    for (int i = 0; i < 26; ++i) p.in[i] = (const float*)d_in[i];
    p.out = (float*)d_out; p.ws = (unsigned char*)d_ws;
    if (hipMemsetAsync((char*)d_ws + mk::W_BAR, 0, 16384, stream) != hipSuccess) { fprintf(stderr, "kernel_launch: memset of the barrier words failed\n"); return; }
    void* args[] = {&p};
    hipError_t e = hipLaunchCooperativeKernel((void*)mk::fwd_megakernel, dim3(grid), dim3(512), args, mk::LDS_BYTES, stream);
    if (e != hipSuccess) fprintf(stderr, "cooperative launch failed: %s (grid %d)\n", hipGetErrorString(e), grid);
}
```
